# Optimizing an MI355X kernel written in HIP

```python
import jax, jax.numpy as jnp
from jax import lax
import numpy as np

D_MODEL = 1024
BATCH = 16
SEQ = 4096
DEPTH = 1

GRID_W = 64
CTX_LEN = 256
MIX_WIDTH = D_MODEL
RWKV_WIDTH = MIX_WIDTH // 2
HEAD_SIZE = 64
RWKV_HEADS = RWKV_WIDTH // HEAD_SIZE
FNET_WIDTH = MIX_WIDTH - RWKV_WIDTH
FNET_GROUPS = 8
FNET_GROUP_W = FNET_WIDTH // FNET_GROUPS
DECAY_LORA = 64
ICLR_LORA = 64
GATE_LORA = 128
N_DIR = 2
SHIFT_WIDTH = 3 * RWKV_WIDTH + N_DIR * (DECAY_LORA + ICLR_LORA + GATE_LORA)
IN_WIDTH = SHIFT_WIDTH + FNET_WIDTH
N_EXPERTS = 32
TOP_K = 4
D_FF = D_MODEL
SWIGLU_LIMIT = 7.0
SWIGLU_ALPHA = 1.702
EXPERT_BLOCK = 128
DEEPNORM_ALPHA = (2.0 * DEPTH) ** 0.25
DEEPNORM_BETA = (8.0 * DEPTH) ** -0.25
LN_EPS = 1e-5
GN_EPS = 64e-5

kernel_name = "hybrid_rwkv7_fnet_moe_prefix_dit_layer"


def layer_norm(u, g, b):
    u32 = u.astype(jnp.float32)
    mean = jnp.mean(u32, -1, keepdims=True)
    var = jnp.mean(jnp.square(u32 - mean), -1, keepdims=True)
    return ((u32 - mean) * lax.rsqrt(var + LN_EPS) * g + b).astype(u.dtype)


def grid_shift(u):
    b_, t, ch = u.shape
    rows = t // GRID_W
    g = u.reshape(b_, rows, GRID_W, ch)
    p = jnp.pad(g, ((0, 0), (1, 1), (1, 1), (0, 0)))
    nb = (p[:, :-2, 1:-1] + p[:, 2:, 1:-1] + p[:, 1:-1, :-2] + p[:, 1:-1, 2:]) * 0.25
    return nb.reshape(b_, t, ch)


def seq_shift(u):
    p = jnp.pad(u, ((0, 0), (1, 1), (0, 0)))
    return (p[:, :-2] + p[:, 2:]) * 0.5


def heads(z):
    return z.reshape(z.shape[:-1] + (RWKV_HEADS, HEAD_SIZE))


def rwkv_prepare(m, w0, w2_decay, a0, a2_iclr, g2_gate, k_k, k_a):
    b_, t, _ = m.shape
    c = RWKV_WIDTH
    r = m[..., :c]
    k = m[..., c:2 * c]
    v = m[..., 2 * c:3 * c]
    o = 3 * c
    wd = m[..., o:o + N_DIR * DECAY_LORA].reshape(b_, t, N_DIR, DECAY_LORA)
    o += N_DIR * DECAY_LORA
    ad = m[..., o:o + N_DIR * ICLR_LORA].reshape(b_, t, N_DIR, ICLR_LORA)
    o += N_DIR * ICLR_LORA
    gd = m[..., o:o + N_DIR * GATE_LORA].reshape(b_, t, N_DIR, GATE_LORA)
    w_log = w0 + jnp.einsum('btdr,drc->btdc', jnp.tanh(wd), w2_decay)
    w = jnp.exp(-jnp.exp(-jax.nn.softplus(-w_log) - 0.5))
    a = jax.nn.sigmoid(a0 + jnp.einsum('btdr,drc->btdc', ad, a2_iclr))
    g = jnp.einsum('btdr,drc->btdc', jax.nn.sigmoid(gd), g2_gate)
    kk = heads(k * k_k)
    kk = kk / jnp.maximum(jnp.sqrt(jnp.sum(jnp.square(kk), -1, keepdims=True)), 1e-12)
    k_d = k[:, :, None] * (1.0 + (a - 1.0) * k_a)
    return heads(r), heads(k_d), heads(v), kk, heads(w), heads(a), g


def wkv_bidir(r, k_d, v, kk, w, a, state0):
    def both(u):
        return jnp.stack([u, jnp.flip(u, 1)], 0)

    def per(u):
        return jnp.stack([u[:, :, 0], jnp.flip(u[:, :, 1], 1)], 0)

    def tm(z):
        return jnp.moveaxis(z, 2, 0)

    xs = (tm(both(r)), tm(per(w)), tm(per(k_d)), tm(both(v)), tm(both(-kk)), tm(per(kk[:, :, None] * a)))

    def step(s, inp):
        r_t, w_t, k_t, v_t, aa_t, bb_t = inp
        sa = jnp.einsum('dbhij,dbhj->dbhi', s, aa_t)
        s = s * w_t[..., None, :] + sa[..., :, None] * bb_t[..., None, :] + v_t[..., :, None] * k_t[..., None, :]
        y_t = jnp.einsum('dbhij,dbhj->dbhi', s, r_t)
        return s, y_t

    state, ys = lax.scan(step, state0, xs)
    ys = jnp.moveaxis(ys, 0, 2)
    y = jnp.stack([ys[0], jnp.flip(ys[1], 1)], axis=2)
    return y, state


def rwkv_output(y, r, k_d, v, g, r_k, gn_g, gn_b):
    b_, t = y.shape[:2]
    mean = jnp.mean(y, -1, keepdims=True)
    var = jnp.mean(jnp.square(y - mean), -1, keepdims=True)
    yn = (y - mean) * lax.rsqrt(var + GN_EPS) * heads(gn_g) + heads(gn_b)
    bonus = jnp.sum(r[:, :, None] * k_d * r_k, -1, keepdims=True) * v[:, :, None]
    return jnp.sum((yn + bonus).reshape(b_, t, N_DIR, RWKV_WIDTH) * g, axis=2)


def fourier_mix(f, w_fno, b_fno):
    b_, t, _ = f.shape
    fg = f.reshape(b_, t, FNET_GROUPS, FNET_GROUP_W).astype(jnp.float32)
    spec = jnp.real(jnp.fft.fft2(fg, axes=(1, 3), norm='ortho'))
    y = jnp.einsum('btgc,gce->btge', spec, w_fno) + b_fno
    return y.reshape(b_, t, FNET_WIDTH)


def token_mixer(h_lat, h_ctx, w_in, mu_shift, w0, w2_decay, a0, a2_iclr, g2_gate, r_k, k_k, k_a,
                gn_g, gn_b, w_fno, b_fno, w_out, need_ctx):
    f32 = jnp.float32
    p_lat = jnp.einsum('btd,de->bte', h_lat, w_in).astype(f32)
    p_ctx = jnp.einsum('btd,de->bte', h_ctx, w_in).astype(f32)
    s_lat, f_lat = p_lat[..., :SHIFT_WIDTH], p_lat[..., SHIFT_WIDTH:]
    s_ctx, f_ctx = p_ctx[..., :SHIFT_WIDTH], p_ctx[..., SHIFT_WIDTH:]
    mu = mu_shift.astype(f32)
    m_lat = s_lat + mu * (grid_shift(s_lat) - s_lat)
    m_ctx = s_ctx + mu * (seq_shift(s_ctx) - s_ctx)
    dp = (w0, w2_decay, a0, a2_iclr, g2_gate, k_k, k_a)
    r_c, k_c, v_c, kk_c, w_c, a_c, g_c = rwkv_prepare(m_ctx, *dp)
    state0 = jnp.zeros((N_DIR, h_ctx.shape[0], RWKV_HEADS, HEAD_SIZE, HEAD_SIZE), f32)
    y_c, state_c = wkv_bidir(r_c, k_c, v_c, kk_c, w_c, a_c, state0)
    r_l, k_l, v_l, kk_l, w_l, a_l, g_l = rwkv_prepare(m_lat, *dp)
    y_l, _ = wkv_bidir(r_l, k_l, v_l, kk_l, w_l, a_l, state_c)
    rw_lat = rwkv_output(y_l, r_l, k_l, v_l, g_l, r_k, gn_g, gn_b)
    out_lat = jnp.concatenate([rw_lat, fourier_mix(f_lat, w_fno, b_fno)], -1) @ w_out.astype(f32)
    out_ctx = None
    if need_ctx:
        rw_ctx = rwkv_output(y_c, r_c, k_c, v_c, g_c, r_k, gn_g, gn_b)
        out_ctx = (jnp.concatenate([rw_ctx, fourier_mix(f_ctx, w_fno, b_fno)], -1) @ w_out.astype(f32)).astype(h_ctx.dtype)
    return out_lat.astype(h_lat.dtype), out_ctx


def moe_ffn(h, w_router, b_router, w1, b1, w2, b2):
    f32 = jnp.float32
    n_tok = h.shape[0]
    logits = h.astype(f32) @ w_router.astype(f32) + b_router.astype(f32)
    top_val, top_idx = lax.top_k(logits, TOP_K)
    gates = jax.nn.softmax(top_val, axis=-1)
    n_assign = n_tok * TOP_K
    e_flat = top_idx.reshape(-1).astype(jnp.int32)
    tok_flat = jnp.repeat(jnp.arange(n_tok, dtype=jnp.int32), TOP_K)
    g_flat = gates.reshape(-1)
    order = jnp.argsort(e_flat)
    e_s, tok_s, g_s = e_flat[order], tok_flat[order], g_flat[order]
    counts = jnp.bincount(e_flat, length=N_EXPERTS).astype(jnp.int32)
    starts = jnp.cumsum(counts) - counts
    padded = (counts + EXPERT_BLOCK - 1) // EXPERT_BLOCK * EXPERT_BLOCK
    pends = jnp.cumsum(padded)
    pstarts = pends - padded
    slot = pstarts[e_s] + jnp.arange(n_assign, dtype=jnp.int32) - starts[e_s]
    n_blocks = -(-n_assign // EXPERT_BLOCK) + N_EXPERTS
    n_slots = n_blocks * EXPERT_BLOCK
    slot_tok = jnp.zeros((n_slots,), jnp.int32).at[slot].set(tok_s)
    slot_gate = jnp.zeros((n_slots,), f32).at[slot].set(g_s)
    block_start = jnp.arange(n_blocks, dtype=jnp.int32) * EXPERT_BLOCK
    block_e = jnp.minimum(jnp.searchsorted(pends, block_start, side='right'), N_EXPERTS - 1)

    def expert_block(args):
        tok_b, e = args
        xb = h[tok_b]
        u = xb @ w1[e] + b1[e]
        glu = jnp.minimum(u[:, 0::2], SWIGLU_LIMIT)
        lin = jnp.clip(u[:, 1::2], -SWIGLU_LIMIT, SWIGLU_LIMIT)
        act = glu * jax.nn.sigmoid(SWIGLU_ALPHA * glu) * (lin + 1.0)
        return act @ w2[e] + b2[e]

    y = lax.map(expert_block, (slot_tok.reshape(n_blocks, EXPERT_BLOCK), block_e))
    out = jnp.zeros((n_tok, h.shape[1]), f32).at[slot_tok].add(slot_gate[:, None] * y.reshape(n_slots, -1))
    return out.astype(h.dtype)


def setup_inputs(seed: int = 0) -> dict:
    key = jax.random.key(seed)
    ks = iter(jax.random.split(key, 48))
    f32 = jnp.float32

    def nrm(shape, scale):
        return scale * jax.random.normal(next(ks), shape, f32)

    L, C, H, N = DEPTH, RWKV_WIDTH, RWKV_HEADS, HEAD_SIZE
    x = nrm((BATCH, SEQ, D_MODEL), 1.0)
    c = nrm((BATCH, D_MODEL), 1.0)
    ctx = nrm((BATCH, CTX_LEN, D_MODEL), 1.0)
    c_ctx = nrm((D_MODEL,), 1.0)
    ln0_g = 1.0 + nrm((D_MODEL,), 0.05)
    ln0_b = nrm((D_MODEL,), 0.02)
    w_ada = nrm((L, D_MODEL, 6 * D_MODEL), 0.5 * D_MODEL ** -0.5)
    b_ada = nrm((L, 6 * D_MODEL), 0.02)
    w_in = nrm((L, D_MODEL, IN_WIDTH), D_MODEL ** -0.5)
    w_in = w_in.at[:, :, 2 * C:3 * C].multiply(DEEPNORM_BETA)
    mu_shift = jax.random.uniform(next(ks), (L, SHIFT_WIDTH), f32, 0.2, 0.8)
    w0 = jax.random.uniform(next(ks), (L, N_DIR, C), f32, -6.0, 1.0)
    w2_decay = nrm((L, N_DIR, DECAY_LORA, C), 0.5 * DECAY_LORA ** -0.5)
    a0 = nrm((L, N_DIR, C), 0.5)
    a2_iclr = nrm((L, N_DIR, ICLR_LORA, C), 0.5 * ICLR_LORA ** -0.5)
    g2_gate = nrm((L, N_DIR, GATE_LORA, C), GATE_LORA ** -0.5)
    r_k = nrm((L, N_DIR, H, N), 0.1)
    k_k = 0.85 + nrm((L, C), 0.05)
    k_a = 1.0 + nrm((L, C), 0.05)
    gn_g = 1.0 + nrm((L, C), 0.05)
    gn_b = nrm((L, C), 0.02)
    w_fno = nrm((L, FNET_GROUPS, FNET_GROUP_W, FNET_GROUP_W), FNET_GROUP_W ** -0.5)
    b_fno = nrm((L, FNET_GROUPS, FNET_GROUP_W), 0.02)
    w_out = nrm((L, MIX_WIDTH, D_MODEL), DEEPNORM_BETA * MIX_WIDTH ** -0.5)
    ln1_g = 1.0 + nrm((L, D_MODEL), 0.05)
    ln1_b = nrm((L, D_MODEL), 0.02)
    w_router = nrm((L, D_MODEL, N_EXPERTS), D_MODEL ** -0.5)
    b_router = nrm((L, N_EXPERTS), 0.01)
    w1 = nrm((L, N_EXPERTS, D_MODEL, 2 * D_FF), D_MODEL ** -0.5)
    b1 = nrm((L, N_EXPERTS, 2 * D_FF), 0.02)
    w2 = nrm((L, N_EXPERTS, D_FF, D_MODEL), DEEPNORM_BETA * D_FF ** -0.5)
    b2 = nrm((L, N_EXPERTS, D_MODEL), 0.02)
    ln2_g = 1.0 + nrm((L, D_MODEL), 0.05)
    ln2_b = nrm((L, D_MODEL), 0.02)
    return {"x": x, "c": c, "ctx": ctx, "c_ctx": c_ctx, "ln0_g": ln0_g, "ln0_b": ln0_b,
            "w_ada": w_ada, "b_ada": b_ada, "w_in": w_in, "mu_shift": mu_shift, "w0": w0,
            "w2_decay": w2_decay, "a0": a0, "a2_iclr": a2_iclr, "g2_gate": g2_gate, "r_k": r_k,
            "k_k": k_k, "k_a": k_a, "gn_g": gn_g, "gn_b": gn_b, "w_fno": w_fno, "b_fno": b_fno,
            "w_out": w_out, "ln1_g": ln1_g, "ln1_b": ln1_b, "w_router": w_router, "b_router": b_router,
            "w1": w1, "b1": b1, "w2": w2, "b2": b2, "ln2_g": ln2_g, "ln2_b": ln2_b}


def reference(x, c, ctx, c_ctx, ln0_g, ln0_b, w_ada, b_ada, w_in, mu_shift, w0, w2_decay, a0, a2_iclr,
              g2_gate, r_k, k_k, k_a, gn_g, gn_b, w_fno, b_fno, w_out, ln1_g, ln1_b, w_router, b_router,
              w1, b1, w2, b2, ln2_g, ln2_b):
    x = layer_norm(x, ln0_g, ln0_b)
    ctx = layer_norm(ctx, ln0_g, ln0_b)
    for l in range(DEPTH):
        need_ctx = l < DEPTH - 1
        mod = (jax.nn.silu(c) @ w_ada[l] + b_ada[l])[:, None, :]
        sh1, sc1, gt1, sh2, sc2, gt2 = jnp.split(mod, 6, axis=-1)
        mod_c = jax.nn.silu(c_ctx) @ w_ada[l] + b_ada[l]
        sh1c, sc1c, gt1c, sh2c, sc2c, gt2c = jnp.split(mod_c, 6, axis=-1)
        h = x * (1.0 + sc1) + sh1
        hc = ctx * (1.0 + sc1c) + sh1c
        mo, mo_c = token_mixer(h, hc, w_in[l], mu_shift[l], w0[l], w2_decay[l], a0[l], a2_iclr[l], g2_gate[l],
                               r_k[l], k_k[l], k_a[l], gn_g[l], gn_b[l], w_fno[l], b_fno[l], w_out[l], need_ctx)
        x = layer_norm(DEEPNORM_ALPHA * x + gt1 * mo, ln1_g[l], ln1_b[l])
        h = x * (1.0 + sc2) + sh2
        f = moe_ffn(h.reshape(-1, D_MODEL), w_router[l], b_router[l], w1[l], b1[l], w2[l], b2[l]).reshape(x.shape)
        x = layer_norm(DEEPNORM_ALPHA * x + gt2 * f, ln2_g[l], ln2_b[l])
        if need_ctx:
            ctx = layer_norm(DEEPNORM_ALPHA * ctx + gt1c * mo_c, ln1_g[l], ln1_b[l])
            hc = ctx * (1.0 + sc2c) + sh2c
            fc = moe_ffn(hc.reshape(-1, D_MODEL), w_router[l], b_router[l], w1[l], b1[l], w2[l], b2[l]).reshape(ctx.shape)
            ctx = layer_norm(DEEPNORM_ALPHA * ctx + gt2c * fc, ln2_g[l], ln2_b[l])
    return x
```

```cpp
#include <hip/hip_runtime.h>
#include <cstdio>
#include <cstdint>

#define GAS __attribute__((address_space(1)))
#define LAS __attribute__((address_space(3)))
typedef unsigned short bf16_t;
typedef short bf16x8 __attribute__((ext_vector_type(8)));
typedef float f32x4 __attribute__((ext_vector_type(4)));
typedef float f32x2 __attribute__((ext_vector_type(2)));
typedef unsigned u32x4 __attribute__((ext_vector_type(4)));
typedef unsigned u32x2 __attribute__((ext_vector_type(2)));
typedef int i32x4 __attribute__((ext_vector_type(4)));
typedef int i32x8 __attribute__((ext_vector_type(8)));
typedef GAS unsigned gu32;
#define RLX_AGENT __ATOMIC_RELAXED, __HIP_MEMORY_SCOPE_AGENT
#define LDS_WAIT() asm volatile("s_waitcnt lgkmcnt(0)" ::: "memory")
#define VM_WAIT() asm volatile("s_waitcnt vmcnt(0)" ::: "memory")

__device__ __forceinline__ unsigned f2bf(float f) { unsigned u = __builtin_bit_cast(unsigned, f); return (u + 0x7fffu + ((u >> 16) & 1u)) >> 16; }
typedef __bf16 bf16x2_t_ __attribute__((ext_vector_type(2)));
__device__ __forceinline__ unsigned pk2(float lo, float hi) { const f32x2 v = {lo, hi}; return __builtin_bit_cast(unsigned, __builtin_convertvector(v, bf16x2_t_)); }
__device__ __forceinline__ float bflo(unsigned w) { return __builtin_bit_cast(float, w << 16); }
__device__ __forceinline__ float bfhi(unsigned w) { return __builtin_bit_cast(float, w & 0xffff0000u); }
__device__ __forceinline__ float frcp(float x) { return __builtin_amdgcn_rcpf(x); }
__device__ __forceinline__ float frsq(float x) { return __builtin_amdgcn_rsqf(x); }
__device__ __forceinline__ float sigmoidf_(float x) { return frcp(1.0f + __expf(-x)); }

template <int CTRL> __device__ __forceinline__ float dpp_mov(float v) { return __builtin_bit_cast(float, __builtin_amdgcn_update_dpp(0, __builtin_bit_cast(int, v), CTRL, 0xF, 0xF, false)); }
__device__ __forceinline__ float red8(float v) { v += dpp_mov<0xB1>(v); v += dpp_mov<0x4E>(v); v += dpp_mov<0x141>(v); return v; }
__device__ __forceinline__ float red16(float v) { v = red8(v); v += dpp_mov<0x140>(v); return v; }
template <int CTRL, int RM> __device__ __forceinline__ float dpp_mov_rm(float v) { return __builtin_bit_cast(float, __builtin_amdgcn_update_dpp(0, __builtin_bit_cast(int, v), CTRL, RM, 0xF, false)); }
__device__ __forceinline__ float wave_sum(float v) {
    v = red16(v); v += dpp_mov_rm<0x142, 0xA>(v); v += dpp_mov_rm<0x143, 0xC>(v);
    return __builtin_bit_cast(float, __builtin_amdgcn_readlane(__builtin_bit_cast(int, v), 63));
}
__device__ __forceinline__ float wave_max(float v) {
    v = fmaxf(v, dpp_mov<0xB1>(v)); v = fmaxf(v, dpp_mov<0x4E>(v)); v = fmaxf(v, dpp_mov<0x141>(v)); v = fmaxf(v, dpp_mov<0x140>(v));
    v = fmaxf(v, __shfl_xor(v, 16)); v = fmaxf(v, __shfl_xor(v, 32));
    return v;
}

#define XB_TMO      128
#define XB_XCNT(j)  (256  + 64 * (j))
#define XB_XSUB(j)  (1280 + 64 * (j))
#define XB_XGEN(j)  (2304 + 64 * (j))
#define XB_TOP      3328
#define XB_TOPGEN   3392
#define XCD_BAR_WORDS 3456
#define XB_SPIN_CAP (1u << 18)
__device__ __forceinline__ unsigned xb_ld(unsigned* p)              { return __hip_atomic_load(p, __ATOMIC_RELAXED, __HIP_MEMORY_SCOPE_AGENT); }
__device__ __forceinline__ unsigned xb_add(unsigned* p, unsigned v) { return __hip_atomic_fetch_add(p, v, __ATOMIC_RELAXED, __HIP_MEMORY_SCOPE_AGENT); }
__device__ __forceinline__ unsigned xb_xcc_id() { return (unsigned)__builtin_amdgcn_s_getreg((3 << 11) | 20) & 0xFu; }
#define XB_SPIN(cond, bar) do { unsigned _sp = 0; while (cond) { __builtin_amdgcn_s_sleep(1); \
    if ((++_sp & 255u) == 0u) { if (xb_ld(&(bar)[XB_TMO])) break; if (_sp > XB_SPIN_CAP) { atomicAdd(&(bar)[XB_TMO], 1u); break; } } } } while (0)
struct XcdBarrier { unsigned* bar; unsigned x; volatile LAS unsigned* st; };
__device__ __forceinline__ XcdBarrier xcd_barrier_post(unsigned* bar, volatile LAS unsigned* st) {
    XcdBarrier b; b.bar = bar; b.x = xb_xcc_id(); b.st = st;
    if (threadIdx.x == 0) (void)xb_add(&bar[XB_XCNT(b.x)], 1u);
    return b;
}
__device__ __forceinline__ void xcd_barrier_complete(unsigned* bar, unsigned x, unsigned& nloc, unsigned& nx) {
    const unsigned G = gridDim.x * gridDim.y * gridDim.z;
    unsigned sum, cnt, mine, sp = 0u;
    for (;;) {
        sum = 0u; cnt = 0u; mine = 0u;
#pragma unroll
        for (unsigned j = 0; j < 16; ++j) { const unsigned c = xb_ld(&bar[XB_XCNT(j)]); sum += c; cnt += (c > 0u) ? 1u : 0u; mine = (j == x) ? c : mine; }
        if (sum == G) break;
        __builtin_amdgcn_s_sleep(1);
        if ((++sp & 255u) == 0u) { if (xb_ld(&bar[XB_TMO])) break; if (sp > XB_SPIN_CAP) { atomicAdd(&bar[XB_TMO], 1u); break; } }
    }
    nloc = mine > 0u ? mine : 1u; nx = cnt > 0u ? cnt : 1u;
}
__device__ __forceinline__ void xcd_barrier(const XcdBarrier& b) {
    asm volatile("s_waitcnt vmcnt(0)" ::: "memory");
    __syncthreads();
    if (threadIdx.x == 0) {
        unsigned* bar = b.bar;
        __builtin_amdgcn_s_waitcnt(0);
        unsigned nloc = b.st[0], nx = b.st[1];
        if (nloc == 0u) { xcd_barrier_complete(bar, b.x, nloc, nx); b.st[0] = nloc; b.st[1] = nx; }
        const unsigned old = xb_add(&bar[XB_XSUB(b.x)], 1u);
        const unsigned gen = old / nloc;
        if (old + 1u == (gen + 1u) * nloc) {
            __builtin_amdgcn_fence(__ATOMIC_RELEASE, "agent");
            asm volatile("s_waitcnt vmcnt(0)" ::: "memory");
            const unsigned og = xb_add(&bar[XB_TOP], 1u);
            const unsigned tg = og / nx;
            if (og + 1u == (tg + 1u) * nx) xb_add(&bar[XB_TOPGEN], 1u);
            else XB_SPIN(xb_ld(&bar[XB_TOPGEN]) == tg, bar);
            __builtin_amdgcn_fence(__ATOMIC_ACQUIRE, "agent");
            xb_add(&bar[XB_XGEN(b.x)], 1u);
            asm volatile("s_waitcnt vmcnt(0)" ::: "memory");
        } else {
            XB_SPIN(xb_ld(&bar[XB_XGEN(b.x)]) == gen, bar);
            __builtin_amdgcn_fence(__ATOMIC_ACQUIRE, "agent");
            asm volatile("s_waitcnt vmcnt(0)" ::: "memory");
        }
    }
    __syncthreads();
}

namespace pg8 {
constexpr int BM = 256, BK = 64, HALF = 128, HTB = HALF * BK * 2, STAGE_BYTES = 8 * HTB, NXCD = 8, WGM = 8;
__host__ __device__ __forceinline__ int lds_byte(int r, int c) { const int st = (r >> 4) * 2 + (c >> 5), rr = r & 15, cc = c & 31, ob = rr * 64 + cc * 2; return st * 1024 + (ob ^ (((ob >> 9) & 1) << 5)); }
__host__ __device__ __forceinline__ void stage_rc(int b, int& R, int& C) { const int st = b / 1024, sb = b % 1024, swz = sb ^ (((sb >> 9) & 1) << 5); R = (st >> 1) * 16 + swz / 64; C = (st & 1) * 32 + (swz % 64) / 2; }
__host__ __device__ __forceinline__ int perm32(int rho) { const int n = rho >> 4, i = rho & 15; return 8 * (i >> 2) + 4 * n + (i & 3); }

struct Unit { int pm, pn, pb; };
struct Gemm { const void* A; const void* Bt; int lda; int K; const int* gidx; };

__device__ __forceinline__ unsigned cvt_pk_bf16(float lo, float hi) { unsigned r; asm volatile("v_cvt_pk_bf16_f32 %0, %1, %2" : "=v"(r) : "v"(lo), "v"(hi)); return r; }

template <class Epi, class Sched, bool GATHER, bool FP8>
__device__ __forceinline__ void gemm_phase(LAS unsigned char* lds, const Gemm g, const Sched& S, const Epi& E) {
    const int tid = threadIdx.x, wid = __builtin_amdgcn_readfirstlane(tid >> 6), lane = tid & 63, wr = wid >> 2, wc = wid & 3, fr = lane & 15, fq = lane >> 4;
    const int K = g.K, nt = K / 128;
    unsigned voffB[2], baseA[2][2];
#pragma unroll
    for (int i = 0; i < 2; ++i) { int R, C; stage_rc(tid * 16 + i * 8192, R, C);
        const int Rb = Epi::BJM ? (64 * (R >> 5) + 16 * ((R & 15) >> 2) + 4 * ((R >> 4) & 1) + (R & 3)) : Epi::PERM ? ((R & ~31) + perm32(R & 31)) : R;
        voffB[i] = (unsigned)(Rb * K) + 2u * (unsigned)C; baseA[0][i] = (unsigned)R * (unsigned)g.lda + 2u * (unsigned)C; baseA[1][i] = (unsigned)(R + HALF) * (unsigned)g.lda + 2u * (unsigned)C; }
    const size_t kstep = (size_t)(BK * 2);
    const size_t hstepB = Epi::BJM ? (size_t)8 * K : (size_t)HALF * K;
    const size_t tstepB = (size_t)BM * K;
    const size_t tstepA = (size_t)BM * (size_t)g.lda;
    const unsigned ldsw = (unsigned)wid * 1024u;
    const int aoff = lds_byte(wr * 64 + fr, fq * 8), boff = lds_byte(wc * 32 + fr, fq * 8);
#define PG8_SA(b, h) (((b) * 2 + (h)) * HTB)
#define PG8_SB(b, h) ((4 + (b) * 2 + (h)) * HTB)
#define PG8_STAGE(bufoff, gbase, voff) do { _Pragma("unroll") for (int _i = 0; _i < 2; ++_i) \
        __builtin_amdgcn_global_load_lds((const unsigned*)((const char*)(gbase) + (voff)[_i]), (LAS unsigned*)(lds + (bufoff) + ldsw + _i * 8192), 16, 0, 0); } while (0)
#define PG8_STAGE_A(bufoff, kb_, nx_, h_) do { if constexpr (GATHER) { _Pragma("unroll") for (int _i = 0; _i < 2; ++_i) \
            __builtin_amdgcn_global_load_lds((const unsigned*)(Ab + (kb_) + ((nx_) ? oN[h_][_i] : oC[h_][_i])), (LAS unsigned*)(lds + (bufoff) + ldsw + _i * 8192), 16, 0, 0); } \
        else { const char* _ab = Ab + (kb_) + (size_t)((nx_) ? pmN : pmC) * tstepA; _Pragma("unroll") for (int _i = 0; _i < 2; ++_i) \
            __builtin_amdgcn_global_load_lds((const unsigned*)(_ab + baseA[h_][_i]), (LAS unsigned*)(lds + (bufoff) + ldsw + _i * 8192), 16, 0, 0); } } while (0)
#define PG8_LDA(dst, b, h) do { if constexpr (FP8) { _Pragma("unroll") for (int m = 0; m < 4; ++m) dst##8[m] = __builtin_shufflevector(*(const LAS i32x4*)(lds + PG8_SA(b, h) + aoff + m * 2048), *(const LAS i32x4*)(lds + PG8_SA(b, h) + aoff + m * 2048 + 1024), 0, 1, 2, 3, 4, 5, 6, 7); } \
        else { _Pragma("unroll") for (int m = 0; m < 4; ++m) _Pragma("unroll") for (int k = 0; k < 2; ++k) dst[m][k] = *(const LAS bf16x8*)(lds + PG8_SA(b, h) + aoff + m * 2048 + k * 1024); } } while (0)
#define PG8_LDB(dst, b, h) do { if constexpr (FP8) { _Pragma("unroll") for (int n = 0; n < 2; ++n) dst##8[n] = __builtin_shufflevector(*(const LAS i32x4*)(lds + PG8_SB(b, h) + boff + n * 2048), *(const LAS i32x4*)(lds + PG8_SB(b, h) + boff + n * 2048 + 1024), 0, 1, 2, 3, 4, 5, 6, 7); } \
        else { _Pragma("unroll") for (int n = 0; n < 2; ++n) _Pragma("unroll") for (int k = 0; k < 2; ++k) dst[n][k] = *(const LAS bf16x8*)(lds + PG8_SB(b, h) + boff + n * 2048 + k * 1024); } } while (0)
#define PG8_MMA(ai, bj, At, Bt) do { __builtin_amdgcn_s_setprio(1); \
        if constexpr (FP8) { _Pragma("unroll") for (int m = 0; m < 4; ++m) _Pragma("unroll") for (int n = 0; n < 2; ++n) \
            asm volatile("v_mfma_f32_16x16x128_f8f6f4 %0, %1, %2, %0" : "+v"(acc[ai][bj][m][n]) : "v"(Bt##8[n]), "v"(At##8[m])); } \
        else { _Pragma("unroll") for (int m = 0; m < 4; ++m) _Pragma("unroll") for (int n = 0; n < 2; ++n) _Pragma("unroll") for (int k = 0; k < 2; ++k) \
            acc[ai][bj][m][n] = __builtin_amdgcn_mfma_f32_16x16x32_bf16(Bt[n][k], At[m][k], acc[ai][bj][m][n], 0, 0, 0); } \
        __builtin_amdgcn_s_setprio(0); } while (0)
#define PG8_WAIT_V(n) asm volatile("s_waitcnt vmcnt(" #n ")" ::: "memory")
#define PG8_WAIT_L(n) asm volatile("s_waitcnt lgkmcnt(" #n ")" ::: "memory")
#define PG8_BAR __builtin_amdgcn_s_barrier()
#define PG8_SCHED __builtin_amdgcn_sched_barrier(0)
#define PG8_AOFF(o, u) do { _Pragma("unroll") for (int _i = 0; _i < 2; ++_i) { int _R, _C; stage_rc(tid * 16 + _i * 8192, _R, _C); \
        _Pragma("unroll") for (int _h = 0; _h < 2; ++_h) { const int _src = g.gidx[(u).pm * BM + _h * HALF + _R]; o[_h][_i] = (unsigned)_src * (unsigned)g.lda + 2u * (unsigned)_C; } } } while (0)
    Unit cur, nxt; int ui = 0;
    if (!S.next(0, cur)) return;
    f32x4 acc[2][2][4][2];
#pragma unroll
    for (int a = 0; a < 2; ++a)
#pragma unroll
        for (int b = 0; b < 2; ++b)
#pragma unroll
            for (int m = 0; m < 4; ++m)
#pragma unroll
                for (int n = 0; n < 2; ++n) acc[a][b][m][n] = (f32x4){0.f, 0.f, 0.f, 0.f};
    bf16x8 At[4][2], B0[2][2], B1[2][2];
    i32x8 At8[4], B08[2], B18[2];
    unsigned oC[2][2], oN[2][2];
    int pmC = cur.pm, pmN = cur.pm;
    if constexpr (GATHER) { PG8_AOFF(oC, cur); }
    const char* const Ab = (const char*)g.A;
    const char* cB = (const char*)g.Bt + (size_t)cur.pb * tstepB;
    PG8_STAGE(PG8_SB(0, 0), cB, voffB); PG8_STAGE(PG8_SB(0, 1), cB + hstepB, voffB); PG8_STAGE_A(PG8_SA(0, 0), 0, false, 0); PG8_STAGE_A(PG8_SA(0, 1), 0, false, 1);
    if (wr == 1) PG8_BAR;
    PG8_WAIT_V(2); PG8_BAR;
    PG8_STAGE(PG8_SB(1, 0), cB + kstep, voffB); PG8_STAGE_A(PG8_SA(1, 0), kstep, false, 0); PG8_STAGE(PG8_SB(1, 1), cB + hstepB + kstep, voffB);
    PG8_WAIT_V(6); PG8_BAR;
    for (;;) {
        const bool has_next = S.next(ui + 1, nxt);
        const char* nB = has_next ? (const char*)g.Bt + (size_t)nxt.pb * tstepB : cB;
        pmN = has_next ? nxt.pm : pmC;
        if constexpr (GATHER) {
            if (has_next && wid < 4) __builtin_amdgcn_global_load_lds((const unsigned*)(g.gidx + nxt.pm * BM + wid * 64 + lane), (LAS unsigned*)(lds + STAGE_BYTES + 8192 + ((ui + 1) & 1) * 1024 + wid * 256), 4, 0, 0);
#pragma unroll
            for (int _h = 0; _h < 2; ++_h)
#pragma unroll
                for (int _i = 0; _i < 2; ++_i) oN[_h][_i] = oC[_h][_i]; }
#pragma unroll 1
        for (int t = 0; t < nt; t += 2) {
            const bool last = (t == nt - 2);
            if constexpr (GATHER) { if (last && has_next) { const LAS int* tb = (const LAS int*)(lds + STAGE_BYTES + 8192 + ((ui + 1) & 1) * 1024);
#pragma unroll
                for (int _i = 0; _i < 2; ++_i) { int _R, _C; stage_rc(tid * 16 + _i * 8192, _R, _C);
#pragma unroll
                    for (int _h = 0; _h < 2; ++_h) oN[_h][_i] = (unsigned)tb[_h * HALF + _R] * (unsigned)g.lda + 2u * (unsigned)_C; } } }
            const size_t k1 = (size_t)(t + 1) * kstep;
            const size_t k2 = last ? 0 : (size_t)(t + 2) * kstep; const char* b2 = last ? nB : cB + (size_t)(t + 2) * kstep;
            const size_t k3 = k2 + kstep; const char* b3 = b2 + kstep;
            const bool after_epi = (t == 0) && (ui > 0);
            PG8_LDB(B0, 0, 0); PG8_LDB(B1, 0, 1); PG8_SCHED; PG8_LDA(At, 0, 0); PG8_STAGE_A(PG8_SA(1, 1), k1, false, 1);
            if (after_epi) { if constexpr (Epi::NST >= 16) { PG8_WAIT_V(24); } else { PG8_WAIT_V(16); } } else { PG8_WAIT_V(8); } PG8_WAIT_L(0); PG8_BAR; PG8_MMA(0, 0, At, B0); PG8_MMA(0, 1, At, B1); PG8_BAR; PG8_SCHED;
            PG8_LDA(At, 0, 1); PG8_STAGE(PG8_SB(0, 0), b2, voffB); PG8_STAGE(PG8_SB(0, 1), b2 + hstepB, voffB); PG8_STAGE_A(PG8_SA(0, 0), k2, last, 0);
            if (after_epi) { if constexpr (Epi::NST >= 16) { PG8_WAIT_V(24); } else { PG8_WAIT_V(16); } } else { PG8_WAIT_V(8); } PG8_WAIT_L(0); PG8_BAR; PG8_MMA(1, 0, At, B0); PG8_MMA(1, 1, At, B1); PG8_BAR; PG8_SCHED;
            PG8_LDB(B0, 1, 0); PG8_LDB(B1, 1, 1); PG8_SCHED; PG8_LDA(At, 1, 0); PG8_STAGE_A(PG8_SA(0, 1), k2, last, 1);
            PG8_WAIT_V(8); PG8_WAIT_L(0); PG8_BAR; PG8_MMA(0, 0, At, B0); PG8_MMA(0, 1, At, B1); PG8_BAR; PG8_SCHED;
            PG8_LDA(At, 1, 1); PG8_STAGE(PG8_SB(1, 0), b3, voffB); PG8_STAGE(PG8_SB(1, 1), b3 + hstepB, voffB); PG8_STAGE_A(PG8_SA(1, 0), k3, last, 0);
            PG8_WAIT_V(8); PG8_WAIT_L(0); PG8_BAR; PG8_MMA(1, 0, At, B0); PG8_MMA(1, 1, At, B1); PG8_BAR; PG8_SCHED;
        }
        if (wr == 0) PG8_BAR;
        if constexpr (FP8) asm volatile("s_nop 15\n\ts_nop 15" ::: "memory");
        E(acc, cur, wr, wc, fr, fq);
        if (!has_next) break;
#pragma unroll
        for (int a = 0; a < 2; ++a)
#pragma unroll
            for (int b = 0; b < 2; ++b)
#pragma unroll
                for (int m = 0; m < 4; ++m)
#pragma unroll
                    for (int n = 0; n < 2; ++n) acc[a][b][m][n] = (f32x4){0.f, 0.f, 0.f, 0.f};
        cur = nxt; cB = nB; pmC = pmN; ++ui;
        if constexpr (GATHER) {
#pragma unroll
            for (int _h = 0; _h < 2; ++_h)
#pragma unroll
                for (int _i = 0; _i < 2; ++_i) oC[_h][_i] = oN[_h][_i]; }
        if (wr == 1) PG8_BAR;
    }
    PG8_WAIT_V(0);
    PG8_BAR;
#undef PG8_SA
#undef PG8_SB
#undef PG8_STAGE
#undef PG8_STAGE_A
#undef PG8_LDA
#undef PG8_LDB
#undef PG8_MMA
#undef PG8_WAIT_V
#undef PG8_WAIT_L
#undef PG8_BAR
#undef PG8_SCHED
#undef PG8_AOFF
}
}
constexpr int D = 1024, NB = 16, T = 4096, TC = 256;
constexpr int ML = NB * T;
constexpr int MC = NB * TC;
constexpr int MT = ML + MC;
constexpr int SW = 2048;
constexpr int NE = 32;
constexpr int MAX_TILES = 1056;
constexpr int SLOT_ROWS = MAX_TILES * 256;
constexpr float LN_EPS = 1e-5f, GN_EPS = 64e-5f;
constexpr float DN_ALPHA = 1.189207115002721f;

constexpr size_t MiB = 1u << 20;
constexpr size_t WS_CTL = 0, CTL_ZERO_BYTES = 1 * MiB;
constexpr size_t WS_MOD = 1 * MiB;
constexpr size_t WS_WINT = 2 * MiB;
constexpr size_t WS_WOUTT = 8 * MiB;
constexpr size_t WS_GATEBT = 10 * MiB;
constexpr size_t WS_MAT1 = 11 * MiB;
constexpr size_t WS_MAT2 = 12 * MiB;
constexpr size_t WS_TOPI = 13 * MiB;
constexpr size_t WS_TOPG = 14 * MiB;
constexpr size_t WS_TOKSLOT = 15 * MiB;
constexpr size_t WS_SLOTTOK = 16 * MiB;
constexpr size_t WS_TILEE = 18 * MiB;
constexpr size_t WS_W2T = 32 * MiB;
constexpr size_t WS_Z1 = 64 * MiB;
constexpr size_t WS_X1 = 64 * MiB;
constexpr size_t WS_H = 192 * MiB;
constexpr size_t WS_MS = 192 * MiB;
constexpr size_t WS_ACT = 192 * MiB;
constexpr size_t WS_H2 = 456 * MiB;
constexpr size_t WS_Y = 456 * MiB;
constexpr size_t WS_PF = 464 * MiB;
constexpr size_t WS_MO = 520 * MiB;
constexpr size_t WS_PS = 592 * MiB;
constexpr size_t WS_MIX = 648 * MiB;
constexpr size_t WS_Z = 776 * MiB;
constexpr size_t WS_END = 1024 * MiB;
constexpr size_t OUT_W1T = 128 * MiB;
static_assert(WS_Y + (size_t)SLOT_ROWS * 1024 <= WS_END && WS_ACT + (size_t)SLOT_ROWS * 1024 <= WS_H2 && WS_MS + (size_t)MT * 4096 <= WS_PF && WS_PS + (size_t)MT * 4096 <= WS_END, "ws map");
constexpr int CW_BAR = 4096;
constexpr int CW_CNT = 8192;
constexpr int CW_CUR = 8320;
constexpr int CW_NT = 8448;

constexpr int RING_BYTES = 131072;
constexpr int LDS_BYTES = 155648;
constexpr int MISC_OFF = LDS_BYTES - 256;

struct SchedGrid {
    int nM, nN, nwg, G, c;
    __device__ void init(int nM_, int nN_, int G_, int c_) { nM = nM_; nN = nN_; nwg = nM * nN; G = G_; c = c_; }
    __device__ bool map(int L, pg8::Unit& u) const {
        int wgid = L; { const int q = nwg / 8, r = nwg % 8, xcd = wgid % 8, off = wgid / 8; wgid = (xcd < r ? xcd * (q + 1) : r * (q + 1) + (xcd - r) * q) + off; }
        const int nig = 8 * nN, gid = wgid / nig, fm = gid * 8, gsz = (nM - fm) < 8 ? (nM - fm) : 8;
        u.pm = fm + ((wgid % nig) % gsz); u.pn = (wgid % nig) / gsz; u.pb = u.pn; return true;
    }
    __device__ bool next(int i, pg8::Unit& u) const { const int L = i * G + c; if (L >= nwg) return false; return map(L, u); }
};
struct SchedInProj {
    SchedGrid g; int G, c;
    __device__ void init(int G_, int c_) { G = G_; c = c_; g.init(ML / 256, 12, G_, c_); }
    __device__ bool next(int i, pg8::Unit& u) const {
        const int L = i * G + c;
        if (L < 3072) return g.map(L, u);
        if (L >= 3072 + 128) return false;
        const int r = L - 3072; u.pm = ML / 256 + r / 8; u.pn = r % 8; u.pb = u.pn; return true;
    }
};
struct SchedMoE {
    int G, c, NT, ntiles; const LAS int* tile_e; bool rev;
    __device__ bool next(int i, pg8::Unit& u) const {
        int rt, pn;
        if (G == 256) { const int x = c & 7, j = c >> 3; const int per = 32 / NT; rt = i * (8 * per) + x * per + j / NT; pn = j % NT; }
        else { const int L = i * G + c; rt = L / NT; pn = L % NT; }
        if (rt >= ntiles) return false;
        if (rev) rt = ntiles - 1 - rt;
        u.pm = rt; u.pn = pn; u.pb = tile_e[rt] * NT + pn; return true;
    }
};

using pg8::Unit; using pg8::cvt_pk_bf16;
struct EpiInProj {
    static constexpr bool PERM = true, BJM = false; static constexpr int NST = 16;
    bf16_t* PS; bf16_t* PF;
    __device__ __forceinline__ void operator()(const f32x4 (&acc)[2][2][4][2], const Unit& u, int wr, int wc, int fr, int fq) const {
        const int row0 = u.pm * 256 + wr * 64 + fr; const int col0 = u.pn * 256 + wc * 32 + 8 * fq;
        bf16_t* base; int ld;
        if (u.pn < 8) { base = PS + col0; ld = 2048; } else { base = PF + (col0 - 2048); ld = 1024; }
#pragma unroll
        for (int ai = 0; ai < 2; ++ai)
#pragma unroll
            for (int m = 0; m < 4; ++m) { bf16_t* rowp = base + (size_t)(row0 + ai * 128 + m * 16) * ld;
#pragma unroll
                for (int bj = 0; bj < 2; ++bj) { const f32x4 v0 = acc[ai][bj][m][0], v1 = acc[ai][bj][m][1];
                    u32x4 w; w.x = cvt_pk_bf16(v0[0], v0[1]); w.y = cvt_pk_bf16(v0[2], v0[3]); w.z = cvt_pk_bf16(v1[0], v1[1]); w.w = cvt_pk_bf16(v1[2], v1[3]);
                    *(u32x4*)(rowp + bj * 128) = w; } }
    }
};
struct EpiBf16Plain {
    static constexpr bool PERM = true, BJM = false; static constexpr int NST = 16;
    bf16_t* O; int ldc;
    __device__ __forceinline__ void operator()(const f32x4 (&acc)[2][2][4][2], const Unit& u, int wr, int wc, int fr, int fq) const {
        const int row0 = u.pm * 256 + wr * 64 + fr; const int col0 = u.pn * 256 + wc * 32 + 8 * fq;
#pragma unroll
        for (int ai = 0; ai < 2; ++ai)
#pragma unroll
            for (int m = 0; m < 4; ++m) { bf16_t* rowp = O + (size_t)(row0 + ai * 128 + m * 16) * ldc + col0;
#pragma unroll
                for (int bj = 0; bj < 2; ++bj) { const f32x4 v0 = acc[ai][bj][m][0], v1 = acc[ai][bj][m][1];
                    u32x4 w; w.x = cvt_pk_bf16(v0[0], v0[1]); w.y = cvt_pk_bf16(v0[2], v0[3]); w.z = cvt_pk_bf16(v1[0], v1[1]); w.w = cvt_pk_bf16(v1[2], v1[3]);
                    *(u32x4*)(rowp + bj * 128) = w; } }
    }
};
struct EpiGate {
    static constexpr bool PERM = true, BJM = false; static constexpr int NST = 8;
    const bf16_t* Z; bf16_t* MIX;
    __device__ __forceinline__ void operator()(const f32x4 (&acc)[2][2][4][2], const Unit& u, int wr, int wc, int fr, int fq) const {
        const int row0 = u.pm * 256 + wr * 64 + fr; const int ch0 = u.pn * 128 + wc * 32 + 8 * fq;
#pragma unroll
        for (int ai = 0; ai < 2; ++ai)
#pragma unroll
            for (int m = 0; m < 4; ++m) { const int row = row0 + ai * 128 + m * 16;
                const u32x4 z0 = *(const u32x4*)(Z + (size_t)row * 512 + ch0), z1 = *(const u32x4*)(Z + ((size_t)ML + row) * 512 + ch0);
                const f32x4 a0 = acc[ai][0][m][0], a1 = acc[ai][0][m][1], b0 = acc[ai][1][m][0], b1 = acc[ai][1][m][1];
                u32x4 w;
                w.x = cvt_pk_bf16(bflo(z0.x) * a0[0] + bflo(z1.x) * b0[0], bfhi(z0.x) * a0[1] + bfhi(z1.x) * b0[1]);
                w.y = cvt_pk_bf16(bflo(z0.y) * a0[2] + bflo(z1.y) * b0[2], bfhi(z0.y) * a0[3] + bfhi(z1.y) * b0[3]);
                w.z = cvt_pk_bf16(bflo(z0.z) * a1[0] + bflo(z1.z) * b1[0], bfhi(z0.z) * a1[1] + bfhi(z1.z) * b1[1]);
                w.w = cvt_pk_bf16(bflo(z0.w) * a1[2] + bflo(z1.w) * b1[2], bfhi(z0.w) * a1[3] + bfhi(z1.w) * b1[3]);
                *(u32x4*)(MIX + (size_t)row * 1024 + ch0) = w; }
    }
};
constexpr float W1_SCALE = 32.0f, W2_SCALE = 64.0f;
struct EpiSwiGLU {
    static constexpr bool PERM = true, BJM = true; static constexpr int NST = 8;
    unsigned char* ACT; const float* b1;
    __device__ __forceinline__ float act1(float g, float l) const {
        g = fminf(g, 7.0f); l = fminf(fmaxf(l, -7.0f), 7.0f);
        return g * sigmoidf_(1.702f * g) * (l + 1.0f);
    }
    __device__ __forceinline__ void operator()(const f32x4 (&acc)[2][2][4][2], const Unit& u, int wr, int wc, int fr, int fq) const {
        const int row0 = u.pm * 256 + wr * 64 + fr; const int col0 = u.pn * 256 + wc * 64 + 16 * fq; const int e = u.pb >> 3;
        f32x4 bv[2][2];
#pragma unroll
        for (int bj = 0; bj < 2; ++bj)
#pragma unroll
            for (int n = 0; n < 2; ++n) bv[bj][n] = *(const f32x4*)(b1 + (size_t)e * 2048 + col0 + bj * 8 + 4 * n);
#pragma unroll
        for (int ai = 0; ai < 2; ++ai)
#pragma unroll
            for (int m = 0; m < 4; ++m) { unsigned char* rowp = ACT + (size_t)(row0 + ai * 128 + m * 16) * 1024 + (col0 >> 1);
                u32x2 w2;
#pragma unroll
                for (int bj = 0; bj < 2; ++bj) { const f32x4 v0 = acc[ai][bj][m][0] * (1.0f / W1_SCALE) + bv[bj][0], v1 = acc[ai][bj][m][1] * (1.0f / W1_SCALE) + bv[bj][1];
                    unsigned w = 0u; w = __builtin_amdgcn_cvt_pk_fp8_f32(act1(v0[0], v0[1]), act1(v0[2], v0[3]), w, false); w = __builtin_amdgcn_cvt_pk_fp8_f32(act1(v1[0], v1[1]), act1(v1[2], v1[3]), w, true);
                    if (bj == 0) w2.x = w; else w2.y = w; }
                *(u32x2*)rowp = w2; }
    }
};
struct EpiY {
    static constexpr bool PERM = true, BJM = true; static constexpr int NST = 8;
    unsigned char* Y; const float* b2;
    __device__ __forceinline__ void operator()(const f32x4 (&acc)[2][2][4][2], const Unit& u, int wr, int wc, int fr, int fq) const {
        const int row0 = u.pm * 256 + wr * 64 + fr; const int col0 = u.pn * 256 + wc * 64 + 16 * fq; const int e = u.pb >> 2;
        f32x4 bv[2][2];
#pragma unroll
        for (int bj = 0; bj < 2; ++bj)
#pragma unroll
            for (int n = 0; n < 2; ++n) bv[bj][n] = *(const f32x4*)(b2 + (size_t)e * 1024 + col0 + bj * 8 + 4 * n);
#pragma unroll
        for (int ai = 0; ai < 2; ++ai)
#pragma unroll
            for (int m = 0; m < 4; ++m) { unsigned char* rowp = Y + (size_t)(row0 + ai * 128 + m * 16) * 1024 + col0;
                u32x4 w;
#pragma unroll
                for (int bj = 0; bj < 2; ++bj) { const f32x4 v0 = acc[ai][bj][m][0] * (1.0f / W2_SCALE) + bv[bj][0], v1 = acc[ai][bj][m][1] * (1.0f / W2_SCALE) + bv[bj][1];
                    unsigned x = 0u; x = __builtin_amdgcn_cvt_pk_fp8_f32(v0[0], v0[1], x, false); x = __builtin_amdgcn_cvt_pk_fp8_f32(v0[2], v0[3], x, true);
                    unsigned y = 0u; y = __builtin_amdgcn_cvt_pk_fp8_f32(v1[0], v1[1], y, false); y = __builtin_amdgcn_cvt_pk_fp8_f32(v1[2], v1[3], y, true);
                    if (bj == 0) { w.x = x; w.y = y; } else { w.z = x; w.w = y; } }
                *(u32x4*)rowp = w; }
    }
};
struct Args { const float* in[33]; float* out; unsigned char* ws; int ph_lo, ph_hi; };
enum { I_X = 0, I_C, I_CTX, I_CCTX, I_LN0G, I_LN0B, I_WADA, I_BADA, I_WIN, I_MU, I_W0, I_W2D, I_A0, I_A2, I_G2, I_RK, I_KK, I_KA, I_GNG, I_GNB, I_WFNO, I_BFNO, I_WOUT,
       I_LN1G, I_LN1B, I_WR, I_BR, I_W1, I_B1, I_W2, I_B2, I_LN2G, I_LN2B };

__device__ __forceinline__ void p0_transpose_item(const float* W, int ldw, int K, bf16_t* WT, int k0, int n0, LAS float* scr, int lane) {
    { float t[32];
#pragma unroll
      for (int i = 0; i < 32; ++i) { const int kk = 2 * i + (lane >> 5); t[i] = W[(size_t)(k0 + kk) * ldw + n0 + (lane & 31)]; }
#pragma unroll
      for (int i = 0; i < 32; ++i) { const int kk = 2 * i + (lane >> 5); scr[kk * 33 + (lane & 31)] = t[i]; } }
    LDS_WAIT(); asm volatile("" ::: "memory");
    const int c = lane & 7;
#pragma unroll
    for (int j = 0; j < 4; ++j) { const int n = (lane >> 3) + 8 * j; const LAS float* s = scr + (8 * c) * 33 + n;
        u32x4 o; o.x = pk2(s[0 * 33], s[1 * 33]); o.y = pk2(s[2 * 33], s[3 * 33]); o.z = pk2(s[4 * 33], s[5 * 33]); o.w = pk2(s[6 * 33], s[7 * 33]);
        *(GAS u32x4*)(WT + (size_t)(n0 + n) * K + k0 + 8 * c) = o; }
    LDS_WAIT(); asm volatile("" ::: "memory");
}

__device__ __forceinline__ void p0_transpose_item_f8(const float* W, int ldw, int K, unsigned char* WT, int k0, int n0, float scale, LAS float* scr, int lane) {
    { float t[32];
#pragma unroll
      for (int i = 0; i < 32; ++i) { const int kk = 2 * i + (lane >> 5); t[i] = W[(size_t)(k0 + kk) * ldw + n0 + (lane & 31)]; }
#pragma unroll
      for (int i = 0; i < 32; ++i) { const int kk = 2 * i + (lane >> 5); scr[kk * 33 + (lane & 31)] = t[i] * scale; } }
    LDS_WAIT(); asm volatile("" ::: "memory");
    const int c = lane & 7;
#pragma unroll
    for (int j = 0; j < 4; ++j) { const int n = (lane >> 3) + 8 * j; const LAS float* s = scr + (8 * c) * 33 + n;
        u32x2 o; unsigned w = 0u;
        w = __builtin_amdgcn_cvt_pk_fp8_f32(s[0 * 33], s[1 * 33], w, false); w = __builtin_amdgcn_cvt_pk_fp8_f32(s[2 * 33], s[3 * 33], w, true); o.x = w;
        w = 0u; w = __builtin_amdgcn_cvt_pk_fp8_f32(s[4 * 33], s[5 * 33], w, false); w = __builtin_amdgcn_cvt_pk_fp8_f32(s[6 * 33], s[7 * 33], w, true); o.y = w;
        *(GAS u32x2*)(WT + (size_t)(n0 + n) * K + k0 + 8 * c) = o; }
    LDS_WAIT(); asm volatile("" ::: "memory");
}

__device__ __forceinline__ void phase0(const Args& a, LAS unsigned char* lds, int vcu, int G, int tid, int wave, int lane) {
    unsigned char* ws = a.ws;
    for (int it = vcu; it < 96 + 128; it += G) {
        if (it < 96) {
            LAS float* s = (LAS float*)lds;
            LAS float* part = s + 1024 * 20;
            for (int idx = tid; idx < 17 * 1024; idx += 512) { const int r = idx >> 10, k = idx & 1023; const float v = r < 16 ? a.in[I_C][r * 1024 + k] : a.in[I_CCTX][k]; s[k * 20 + r] = v * sigmoidf_(v); }
            __syncthreads();
            const int j = it * 64 + lane; float acc[17];
#pragma unroll
            for (int r = 0; r < 17; ++r) acc[r] = 0.f;
            const float* wp = a.in[I_WADA] + (size_t)(128 * wave) * 6144 + j;
#pragma unroll 1
            for (int k0 = 0; k0 < 128; k0 += 32) { float wv[32];
#pragma unroll
                for (int u = 0; u < 32; ++u) wv[u] = wp[(size_t)(k0 + u) * 6144];
#pragma unroll
            for (int u = 0; u < 32; ++u) { const int kk = k0 + u; const float w = wv[u]; const int k = 128 * wave + kk;
                const f32x4 s0 = *(const LAS f32x4*)(s + k * 20), s1 = *(const LAS f32x4*)(s + k * 20 + 4), s2 = *(const LAS f32x4*)(s + k * 20 + 8), s3 = *(const LAS f32x4*)(s + k * 20 + 12); const float s4 = s[k * 20 + 16];
#pragma unroll
                for (int q = 0; q < 4; ++q) { acc[q] += s0[q] * w; acc[4 + q] += s1[q] * w; acc[8 + q] += s2[q] * w; acc[12 + q] += s3[q] * w; }
                acc[16] += s4 * w; } }
#pragma unroll
            for (int r = 0; r < 17; ++r) part[(wave * 17 + r) * 64 + lane] = acc[r];
            __syncthreads();
            float* MOD = (float*)(ws + WS_MOD);
            for (int idx = tid; idx < 17 * 64; idx += 512) { const int r = idx >> 6, l = idx & 63; float t = a.in[I_BADA][it * 64 + l];
#pragma unroll
                for (int w = 0; w < 8; ++w) t += part[(w * 17 + r) * 64 + l];
                MOD[r * 6144 + it * 64 + l] = t; }
            __syncthreads();
        } else {
            const int f = it - 96, g = f >> 4, kb = f & 15;
            LAS float* Wf = (LAS float*)lds;
            LAS float* AB = Wf + 4096;
            LAS float* XT = AB + 8192;
            LAS float* CS = XT + 4096;
            for (int idx = tid; idx < 4096; idx += 512) Wf[idx] = a.in[I_WFNO][(size_t)g * 4096 + idx];
            for (int idx = tid; idx < 4096; idx += 512) { const int kk = idx >> 6, c = idx & 63; XT[c * 64 + kk] = a.in[I_WIN][(size_t)(kb * 64 + kk) * 2560 + 2048 + g * 64 + c]; }
            if (tid < 64) { const float ang = 6.283185307179586f * (float)tid / 64.0f; CS[tid] = cosf(ang); CS[64 + tid] = sinf(ang); }
            __syncthreads();
            { const int c = tid >> 3, e0 = (tid & 7) * 8; float ac[8], as[8];
#pragma unroll
              for (int q = 0; q < 8; ++q) { ac[q] = 0.f; as[q] = 0.f; }
              for (int cp = 0; cp < 64; ++cp) { const int ph = (c * cp) & 63; const float cc = CS[ph], ss = CS[64 + ph];
#pragma unroll
                  for (int q = 0; q < 8; ++q) { const float w = Wf[cp * 64 + e0 + q]; ac[q] += cc * w; as[q] += ss * w; } }
#pragma unroll
              for (int q = 0; q < 8; ++q) { AB[c * 64 + e0 + q] = ac[q] * (1.0f / 512.0f); AB[4096 + c * 64 + e0 + q] = as[q] * (1.0f / 512.0f); } }
            __syncthreads();
            { const int e = tid >> 3, k0 = (tid & 7) * 8; float oc[8], os[8];
#pragma unroll
              for (int q = 0; q < 8; ++q) { oc[q] = 0.f; os[q] = 0.f; }
              for (int c = 0; c < 64; ++c) { const float av = AB[c * 64 + e], bv = AB[4096 + c * 64 + e];
#pragma unroll
                  for (int q = 0; q < 8; ++q) { const float x = XT[c * 64 + k0 + q]; oc[q] += x * av; os[q] += x * bv; } }
              bf16_t* WT = (bf16_t*)(ws + WS_WINT);
              u32x4 o; o.x = pk2(oc[0], oc[1]); o.y = pk2(oc[2], oc[3]); o.z = pk2(oc[4], oc[5]); o.w = pk2(oc[6], oc[7]);
              *(GAS u32x4*)(WT + (size_t)(2048 + g * 64 + e) * 1024 + kb * 64 + k0) = o;
              o.x = pk2(os[0], os[1]); o.y = pk2(os[2], os[3]); o.z = pk2(os[4], os[5]); o.w = pk2(os[6], os[7]);
              *(GAS u32x4*)(WT + (size_t)(2560 + g * 64 + e) * 1024 + kb * 64 + k0) = o; }
            __syncthreads();
        }
    }
    {
        LAS float* scr = (LAS float*)(lds + wave * 8448);
        const int gw = vcu * 8 + wave, NGW = G * 8;
        constexpr int I_IN = 16 * 64, I_OUT = 16 * 32;
        constexpr int NIT = I_IN + I_OUT;
        for (int it = gw; it < NIT; it += NGW) {
            int r = it;
            if (r < I_IN) { p0_transpose_item(a.in[I_WIN], 2560, 1024, (bf16_t*)(ws + WS_WINT), (r / 64) * 64, (r % 64) * 32, scr, lane); continue; } r -= I_IN;
            p0_transpose_item(a.in[I_WOUT], 1024, 1024, (bf16_t*)(ws + WS_WOUTT), (r / 32) * 64, (r % 32) * 32, scr, lane);
        }
    }
    {
        const int gt = vcu * 512 + tid, NGT = G * 512;
        bf16_t* GB = (bf16_t*)(ws + WS_GATEBT);
        for (int it = gt; it < 1024 * 32; it += NGT) { const int n = it >> 5, k0 = (it & 31) * 8; const int pn = n >> 8, dir = (n >> 7) & 1, ch = pn * 128 + (n & 127);
            unsigned w[4];
#pragma unroll
            for (int q = 0; q < 4; ++q) { float v0 = 0.f, v1 = 0.f; const int ka = k0 + 2 * q, kb2 = ka + 1;
                if ((ka >> 7) == dir) { v0 = a.in[I_G2][((size_t)dir * 128 + (ka & 127)) * 512 + ch]; v1 = a.in[I_G2][((size_t)dir * 128 + (kb2 & 127)) * 512 + ch]; }
                w[q] = pk2(v0, v1); }
            *(GAS u32x4*)(GB + (size_t)n * 256 + k0) = (u32x4){w[0], w[1], w[2], w[3]}; }
        bf16_t* M1 = (bf16_t*)(ws + WS_MAT1);
        for (int it = gt; it < 128 * 16; it += NGT) { const int m = it >> 4, k0 = (it & 15) * 8; const int rip = m >> 6, t1p = m & 63; unsigned w[4];
#pragma unroll
            for (int q = 0; q < 4; ++q) { float v[2];
#pragma unroll
                for (int z = 0; z < 2; ++z) { const int k = k0 + 2 * q + z, ri = k >> 6, t1 = k & 63; const float ang = 6.283185307179586f * (float)((t1 * t1p) & 63) / 64.0f; const float cs = cosf(ang), sn = sinf(ang);
                    v[z] = (rip == 0) ? (ri == 0 ? cs : -sn) : (ri == 0 ? sn : cs); }
                w[q] = pk2(v[0], v[1]); }
            *(GAS u32x4*)(M1 + (size_t)m * 128 + k0) = (u32x4){w[0], w[1], w[2], w[3]}; }
        bf16_t* M2 = (bf16_t*)(ws + WS_MAT2);
        for (int it = gt; it < 64 * 64 * 16; it += NGT) { const int t1p = it >> 10, m = (it >> 4) & 63, k0 = (it & 15) * 8; unsigned w[4];
#pragma unroll
            for (int q = 0; q < 4; ++q) { float v[2];
#pragma unroll
                for (int z = 0; z < 2; ++z) { const int k = k0 + 2 * q + z, ri = k >> 6, t2 = k & 63; const float ang = 6.283185307179586f * (float)((t2 * (t1p + 64 * m)) & 4095) / 4096.0f;
                    v[z] = (ri == 0) ? cosf(ang) : -sinf(ang); }
                w[q] = pk2(v[0], v[1]); }
            *(GAS u32x4*)(M2 + ((size_t)t1p * 64 + m) * 128 + k0) = (u32x4){w[0], w[1], w[2], w[3]}; }
    }
}

#define P1_LOAD(dst, row) do { const float* _xr = (row) < ML ? a.in[I_X] + (size_t)(row) * D : a.in[I_CTX] + (size_t)((row) - ML) * D; \
    _Pragma("unroll") for (int j = 0; j < 4; ++j) dst[j] = __builtin_nontemporal_load((const f32x4*)(_xr + 4 * lane + 256 * j)); } while (0)
__device__ __forceinline__ void phase1(const Args& a, int vcu, int G, int wave, int lane) {
    const float* MOD = (const float*)(a.ws + WS_MOD); bf16_t* H = (bf16_t*)(a.ws + WS_H);
    const int gw = vcu * 8 + wave, NGW = G * 8;
    f32x4 g0[4], b0[4];
#pragma unroll
    for (int j = 0; j < 4; ++j) { g0[j] = *(const f32x4*)(a.in[I_LN0G] + 4 * lane + 256 * j); b0[j] = *(const f32x4*)(a.in[I_LN0B] + 4 * lane + 256 * j); }
    int pr = gw * 2;
    f32x4 va[4], vb[4];
    if (pr < MT) { P1_LOAD(va, pr); P1_LOAD(vb, pr + 1); }
    for (; pr < MT; pr += NGW * 2) {
        const int npr = pr + NGW * 2; f32x4 na[4], nb[4];
        const int mr = pr < ML ? (pr >> 12) : 16;
        f32x4 sh[4], sc[4];
#pragma unroll
        for (int j = 0; j < 4; ++j) { sh[j] = *(const f32x4*)(MOD + mr * 6144 + 4 * lane + 256 * j); sc[j] = *(const f32x4*)(MOD + mr * 6144 + 1024 + 4 * lane + 256 * j); }
        asm volatile("" ::: "memory");
        if (npr < MT) { P1_LOAD(na, npr); P1_LOAD(nb, npr + 1); }
        float sa = 0.f, sb = 0.f;
#pragma unroll
        for (int j = 0; j < 4; ++j) { sa += (va[j][0] + va[j][1]) + (va[j][2] + va[j][3]); sb += (vb[j][0] + vb[j][1]) + (vb[j][2] + vb[j][3]); }
        const float ma = wave_sum(sa) * (1.f / D), mb = wave_sum(sb) * (1.f / D); float qa = 0.f, qb = 0.f;
#pragma unroll
        for (int j = 0; j < 4; ++j) { va[j] = va[j] - ma; vb[j] = vb[j] - mb;
            qa += (va[j][0] * va[j][0] + va[j][1] * va[j][1]) + (va[j][2] * va[j][2] + va[j][3] * va[j][3]); qb += (vb[j][0] * vb[j][0] + vb[j][1] * vb[j][1]) + (vb[j][2] * vb[j][2] + vb[j][3] * vb[j][3]); }
        const float ra = frsq(wave_sum(qa) * (1.f / D) + LN_EPS), rb = frsq(wave_sum(qb) * (1.f / D) + LN_EPS);
#pragma unroll
        for (int j = 0; j < 4; ++j) { const int c = 4 * lane + 256 * j;
            const f32x4 ha = (va[j] * ra * g0[j] + b0[j]) * (sc[j] + 1.0f) + sh[j], hb = (vb[j] * rb * g0[j] + b0[j]) * (sc[j] + 1.0f) + sh[j];
            u32x2 o; o.x = pk2(ha[0], ha[1]); o.y = pk2(ha[2], ha[3]); *(GAS u32x2*)(H + (size_t)pr * D + c) = o;
            o.x = pk2(hb[0], hb[1]); o.y = pk2(hb[2], hb[3]); *(GAS u32x2*)(H + (size_t)(pr + 1) * D + c) = o; }
#pragma unroll
        for (int j = 0; j < 4; ++j) { va[j] = na[j]; vb[j] = nb[j]; }
    }
}
#undef P1_LOAD

__device__ __forceinline__ void unpack8(const u32x4 w, float (&f)[8]) { f[0] = bflo(w.x); f[1] = bfhi(w.x); f[2] = bflo(w.y); f[3] = bfhi(w.y); f[4] = bflo(w.z); f[5] = bfhi(w.z); f[6] = bflo(w.w); f[7] = bfhi(w.w); }
__device__ __forceinline__ void acc8(const u32x4 w, float (&f)[8]) { f[0] += bflo(w.x); f[1] += bfhi(w.x); f[2] += bflo(w.y); f[3] += bfhi(w.y); f[4] += bflo(w.z); f[5] += bfhi(w.z); f[6] += bflo(w.w); f[7] += bfhi(w.w); }
__device__ __forceinline__ void shift_out8(const u32x4 c, const u32x4 l, const u32x4 r, const u32x4 u, const u32x4 d, const float (&mu)[8], float scale, int actk, float ns, float al, float be, bf16_t* dst) {
    float sv[8], nb[8];
    unpack8(c, sv);
#pragma unroll
    for (int z = 0; z < 8; ++z) nb[z] = 0.f;
    acc8(l, nb); acc8(r, nb); acc8(u, nb); acc8(d, nb);
    float m[8];
#pragma unroll
    for (int z = 0; z < 8; ++z) m[z] = sv[z] + mu[z] * (nb[z] * scale - sv[z]);
    if (actk != 0) {
#pragma unroll
        for (int z = 0; z < 8; ++z) m[z] = al * frcp(1.0f + __expf(ns * m[z])) + be; }
    u32x4 o; o.x = pk2(m[0], m[1]); o.y = pk2(m[2], m[3]); o.z = pk2(m[4], m[5]); o.w = pk2(m[6], m[7]);
    *(GAS u32x4*)dst = o;
}
__device__ __forceinline__ void phase3_shift(const Args& a, int vcu, int G, int tid) {
    const bf16_t* PS = (const bf16_t*)(a.ws + WS_PS); bf16_t* MS = (bf16_t*)(a.ws + WS_MS);
    const int cb = (tid & 255) * 8; float mu[8];
#pragma unroll
    for (int q = 0; q < 8; ++q) mu[q] = a.in[I_MU][cb + q];
    const int actk = (cb >= 1536 && cb < 1664) ? 1 : (cb >= 1792 ? 2 : 0);
    const float ns = actk == 1 ? -2.0f : -1.0f, al = actk == 1 ? 2.0f : 1.0f, be = actk == 1 ? -1.0f : 0.0f;
    const u32x4 zz = {0u, 0u, 0u, 0u};
    for (int it = vcu * 2 + (tid >> 8); it < 512; it += 2 * G) {
        const int b = it >> 5, r8 = (it >> 2) & 7, seg = it & 3; const int gx0 = 8 * r8, g0 = 16 * seg;
        const bool hasL = gx0 > 0, hasR = gx0 < 56;
        const bf16_t* base = PS + ((size_t)b * 4096 + gx0) * SW + cb;
        u32x4 P[8], C[10], N[10];
#define SH_LOADROW(dst, g) do { const bf16_t* _rp = base + (size_t)(g) * 64 * SW; dst[0] = hasL ? *(const u32x4*)(_rp - SW) : zz; dst[9] = hasR ? *(const u32x4*)(_rp + 8 * SW) : zz; \
        _Pragma("unroll") for (int q = 0; q < 8; ++q) dst[1 + q] = *(const u32x4*)(_rp + (size_t)q * SW); } while (0)
        if (g0 > 0) {
#pragma unroll
            for (int q = 0; q < 8; ++q) P[q] = *(const u32x4*)(base + (size_t)(g0 - 1) * 64 * SW + (size_t)q * SW); }
        else {
#pragma unroll
            for (int q = 0; q < 8; ++q) P[q] = zz; }
        SH_LOADROW(C, g0);
#pragma unroll 1
        for (int g = g0; g < g0 + 16; ++g) {
            if (g < 63) { SH_LOADROW(N, g + 1); } else {
#pragma unroll
                for (int q = 0; q < 10; ++q) N[q] = zz; }
#pragma unroll
            for (int q = 0; q < 8; ++q) shift_out8(C[1 + q], C[q], C[2 + q], P[q], N[1 + q], mu, 0.25f, actk, ns, al, be, MS + ((size_t)b * 4096 + g * 64 + gx0 + q) * SW + cb);
#pragma unroll
            for (int q = 0; q < 8; ++q) P[q] = C[1 + q];
#pragma unroll
            for (int q = 0; q < 10; ++q) C[q] = N[q];
        }
#undef SH_LOADROW
    }
    for (int rn = vcu * 2 + (tid >> 8); rn < MC / 8; rn += 2 * G) {
        const int r0 = ML + rn * 8; const int t0 = (rn * 8) & 255; const bool hasL = t0 > 0, hasR = t0 < 248;
        const bf16_t* base = PS + (size_t)r0 * SW + cb; u32x4 C[10];
        C[0] = hasL ? *(const u32x4*)(base - SW) : zz; C[9] = hasR ? *(const u32x4*)(base + 8 * SW) : zz;
#pragma unroll
        for (int q = 0; q < 8; ++q) C[1 + q] = *(const u32x4*)(base + (size_t)q * SW);
#pragma unroll
        for (int q = 0; q < 8; ++q) shift_out8(C[1 + q], C[q], C[2 + q], zz, zz, mu, 0.5f, actk, ns, al, be, MS + (size_t)(r0 + q) * SW + cb);
    }
}

constexpr int MOE_W_ITEMS = 32768 + 16384;
__device__ __forceinline__ void moe_weight_addr(const Args& a, int item, int lane, const float*& src, unsigned char*& dst, int& ldw, float& scale) {
    const float* W; unsigned char* WT; int k0, n0;
    if (item < 32768) { const int e = item >> 10, r = item & 1023; W = a.in[I_W1] + (size_t)e * 1024 * 2048; ldw = 2048; k0 = (r >> 5) * 32; n0 = (r & 31) * 64; WT = (unsigned char*)a.out + OUT_W1T + (size_t)e * 2048 * 1024; scale = W1_SCALE; }
    else { const int q = item - 32768, e = q >> 9, r = q & 511; W = a.in[I_W2] + (size_t)e * 1024 * 1024; ldw = 1024; k0 = (r >> 4) * 32; n0 = (r & 15) * 64; WT = a.ws + WS_W2T + (size_t)e * 1024 * 1024; scale = W2_SCALE; }
    src = W + (size_t)k0 * ldw + n0 + lane; dst = WT + (size_t)(n0 + lane) * 1024 + k0;
}
__device__ __forceinline__ void moe_weight_dma(const Args& a, int item, int lane, LAS unsigned char* wb) {
    const float* src; unsigned char* dst; int ldw; float scale; moe_weight_addr(a, item, 0, src, dst, ldw, scale);
#pragma unroll
    for (int q = 0; q < 8; ++q) __builtin_amdgcn_global_load_lds((const unsigned*)(src + (size_t)(4 * q + (lane >> 4)) * ldw + (lane & 15) * 4), (LAS unsigned*)(wb + q * 1024), 16, 0, 2);
}
__device__ __forceinline__ void moe_weight_cvt(const Args& a, int item, int lane, const LAS unsigned char* wb) {
    const float* src; unsigned char* dst; int ldw; float scale; moe_weight_addr(a, item, lane, src, dst, ldw, scale);
    float t[32];
#pragma unroll
    for (int i = 0; i < 32; ++i) t[i] = ((const LAS float*)wb)[i * 64 + lane];
    unsigned w[8];
#pragma unroll
    for (int q = 0; q < 8; ++q) { unsigned x = 0u; x = __builtin_amdgcn_cvt_pk_fp8_f32(t[4 * q] * scale, t[4 * q + 1] * scale, x, false); x = __builtin_amdgcn_cvt_pk_fp8_f32(t[4 * q + 2] * scale, t[4 * q + 3] * scale, x, true); w[q] = x; }
    *(GAS u32x4*)dst = (u32x4){w[0], w[1], w[2], w[3]}; *(GAS u32x4*)(dst + 16) = (u32x4){w[4], w[5], w[6], w[7]};
}
typedef short s16x4 __attribute__((ext_vector_type(4)));
#define SWZV(n_, j_) ((n_) * 64 + (((((j_) >> 3) ^ ((((n_) >> 2) & 3) << 1)) << 3) | ((j_) & 7)))
#define SWZ64(n_, j_) ((n_) * 64 + (((((j_) >> 3) ^ ((n_) & 7)) << 3) | ((j_) & 7)))
#define MFMA32(a_, b_, c_) __builtin_amdgcn_mfma_f32_16x16x32_bf16(a_, b_, c_, 0, 0, 0)
__device__ __forceinline__ bf16x8 pk8(const s16x4 lo, const s16x4 hi) { return __builtin_shufflevector(lo, hi, 0, 1, 2, 3, 4, 5, 6, 7); }
#define MFMA16(a_, b_, c_) MFMA32(pk8(a_, (s16x4){0, 0, 0, 0}), pk8(b_, (s16x4){0, 0, 0, 0}), c_)
typedef __bf16 bf16x4_t __attribute__((ext_vector_type(4)));
__device__ __forceinline__ s16x4 cvt4(const f32x4 v) { const bf16x4_t b = __builtin_convertvector(v, bf16x4_t); return __builtin_bit_cast(s16x4, b); }
__device__ __forceinline__ void phase4_scan(const Args& a, LAS unsigned char* lds, int vcu, int G, int tid, int wave, int lane) {
    const bf16_t* MS = (const bf16_t*)(a.ws + WS_MS); bf16_t* Z = (bf16_t*)(a.ws + WS_Z);
    constexpr int FS = 68;
    LAS float* R = (LAS float*)lds; LAS float* KD = (LAS float*)(lds + 17408); LAS float* E = (LAS float*)(lds + 51200); LAS float* BB = (LAS float*)(lds + 68608); LAS unsigned short* Yb = (LAS unsigned short*)(lds + 98304);
    LAS unsigned char* ATb = lds + 34816; LAS unsigned char* RTb = lds + 43008;
    LAS unsigned char* BTb = lds + 122880; LAS unsigned char* KTb = lds + 131072;
    LAS unsigned char* TWb = lds + 122880; LAS unsigned char* ADb = lds + 132096;
    LAS float* BONUS = (LAS float*)(lds + 141312); LAS float* CV = BONUS + 64;
    LAS unsigned short* const VT0 = (LAS unsigned short*)(lds + 143360); LAS unsigned short* const VT1 = (LAS unsigned short*)(lds + 86016);
    LAS float* WL = (LAS float*)(lds + 151552);
    LAS float* INV = (LAS float*)(lds + 152576);
    LAS unsigned char* FRG = lds;
    LAS unsigned char* BFL = lds + 106496;
    const int fr = lane & 15, fq = lane >> 4;
    for (int chain = vcu; chain < 256; chain += G) {
        const int d = chain >> 7, b = (chain >> 3) & 15, h = chain & 7;
        __syncthreads();
        if (tid < 64) { CV[tid] = a.in[I_W0][d * 512 + h * 64 + tid]; CV[64 + tid] = a.in[I_A0][d * 512 + h * 64 + tid]; CV[128 + tid] = a.in[I_KK][h * 64 + tid]; CV[192 + tid] = a.in[I_KA][h * 64 + tid];
            CV[256 + tid] = a.in[I_RK][(d * 8 + h) * 64 + tid]; CV[320 + tid] = a.in[I_GNG][h * 64 + tid]; CV[384 + tid] = a.in[I_GNB][h * 64 + tid]; }
        const int sel = wave >> 2, mt = wave & 3;
        {
            const float* w2d = a.in[I_W2D] + (size_t)d * 64 * 512 + h * 64; const float* a2p = a.in[I_A2] + (size_t)d * 64 * 512 + h * 64;
#pragma unroll 2
            for (int idx = tid; idx < 4096; idx += 512) { const int c = idx >> 6, j = idx & 63; R[idx] = w2d[(size_t)c * 512 + j]; KD[idx] = a2p[(size_t)c * 512 + j]; }
            __syncthreads();
            if (mt == 0) { const LAS float* Wl = sel ? KD : R;
#pragma unroll
                for (int nt = 0; nt < 4; ++nt)
#pragma unroll
                    for (int ks = 0; ks < 2; ++ks) { bf16x8 f;
#pragma unroll
                        for (int jj = 0; jj < 8; ++jj) f[jj] = (short)f2bf(Wl[(32 * ks + 8 * fq + jj) * 64 + 16 * nt + fr]);
                        *(LAS bf16x8*)(BFL + ((sel * 8 + nt * 2 + ks) * 64 + lane) * 16) = f; } }
            __syncthreads();
        }
        f32x4 ST[4];
#pragma unroll
        for (int jt = 0; jt < 4; ++jt) ST[jt] = (f32x4){0.f, 0.f, 0.f, 0.f};
        const int tt = tid >> 3, seg = tid & 7, pn = d ? 63 - tt : tt;
        u32x4 pR, pK, pV, pW, pA;
#define SCAN_BAR() do { LDS_WAIT(); __builtin_amdgcn_s_barrier(); asm volatile("" ::: "memory"); } while (0)
#define SCAN_ROW0(cc) ((cc) < 4 ? (ML + b * 256 + 64 * (d ? 3 - (cc) : (cc))) : (b * 4096 + 64 * (d ? 63 - ((cc) - 4) : ((cc) - 4))))
#define SCAN_LOAD(cc) do { const bf16_t* mrow = MS + (size_t)(SCAN_ROW0(cc) + tt) * SW; \
        pR = *(const u32x4*)(mrow + h * 64 + 8 * seg); pK = *(const u32x4*)(mrow + 512 + h * 64 + 8 * seg); pV = *(const u32x4*)(mrow + 1024 + h * 64 + 8 * seg); \
        pW = *(const u32x4*)(mrow + 1536 + d * 64 + 8 * seg); pA = *(const u32x4*)(mrow + 1664 + d * 64 + 8 * seg); } while (0)
        SCAN_LOAD(0);
        for (int cc = 0; cc < 68; ++cc) {
            const int row0 = SCAN_ROW0(cc); const bool is_lat = cc >= 4;
            LAS unsigned short* const VT = (cc & 1) ? VT1 : VT0;
            if (wave >= 4 && chain == vcu && cc > 0) { const int item = ((cc - 1) * 4 + (wave - 4)) * G + vcu;
                if (item < MOE_W_ITEMS) { asm volatile("s_waitcnt vmcnt(0)" ::: "memory"); moe_weight_cvt(a, item, lane, lds + 51200 + (wave - 4) * 8192); } }
            { float f[8];
              unpack8(pR, f); *(LAS f32x4*)(R + pn * FS + 8 * seg) = (f32x4){f[0], f[1], f[2], f[3]}; *(LAS f32x4*)(R + pn * FS + 8 * seg + 4) = (f32x4){f[4], f[5], f[6], f[7]};
              unpack8(pK, f); *(LAS f32x4*)(KD + pn * FS + 8 * seg) = (f32x4){f[0], f[1], f[2], f[3]}; *(LAS f32x4*)(KD + pn * FS + 8 * seg + 4) = (f32x4){f[4], f[5], f[6], f[7]};
              { float ss = 0.f;
#pragma unroll
                for (int q = 0; q < 8; ++q) { const float kkr = f[q] * CV[128 + 8 * seg + q]; ss += kkr * kkr; }
                ss = red8(ss); if (seg == 0) INV[pn] = frcp(fmaxf(__builtin_amdgcn_sqrtf(ss), 1e-12f)); }
              *(LAS u32x4*)(VT + SWZV(pn, 8 * seg)) = pV;
              *(LAS u32x4*)(TWb + pn * 144 + seg * 16) = pW; *(LAS u32x4*)(ADb + pn * 144 + seg * 16) = pA; }
            SCAN_BAR();
            { const LAS unsigned char* Ab = sel ? ADb : TWb;
              const bf16x8 A0 = *(const LAS bf16x8*)(Ab + (16 * mt + fr) * 144 + 16 * fq), A1 = *(const LAS bf16x8*)(Ab + (16 * mt + fr) * 144 + 64 + 16 * fq);
              LAS float* const dstA = sel ? BB : E; const float mulA = sel ? 1.0f : -0.6065306597126334f; const int cvo = sel ? 64 : 0;
              bf16x8 bq[8]; float cvv[4];
#pragma unroll
              for (int k8 = 0; k8 < 8; ++k8) bq[k8] = *(const LAS bf16x8*)(BFL + ((sel * 8 + k8) * 64 + lane) * 16);
#pragma unroll
              for (int nt = 0; nt < 4; ++nt) cvv[nt] = CV[cvo + 16 * nt + fr];
              __builtin_amdgcn_sched_barrier(0);
              f32x4 acc[4];
#pragma unroll
              for (int nt = 0; nt < 4; ++nt) { acc[nt] = (f32x4){0.f, 0.f, 0.f, 0.f};
                  acc[nt] = __builtin_amdgcn_mfma_f32_16x16x32_bf16(A0, bq[2 * nt], acc[nt], 0, 0, 0); acc[nt] = __builtin_amdgcn_mfma_f32_16x16x32_bf16(A1, bq[2 * nt + 1], acc[nt], 0, 0, 0); }
#pragma unroll
              for (int nt = 0; nt < 4; ++nt)
#pragma unroll
                  for (int rg = 0; rg < 4; ++rg) { const int tok = 16 * mt + 4 * fq + rg, j = 16 * nt + fr;
                      dstA[tok * FS + j] = mulA * sigmoidf_(cvv[nt] + acc[nt][rg]); } }
            SCAN_BAR();
            { const int sc = tid >> 7, tq = (tid >> 5) & 3, jp = tid & 31; f32x2 lw = {0.f, 0.f};
              const f32x2 kkc = *(const LAS f32x2*)(CV + 128 + 2 * jp), kac = *(const LAS f32x2*)(CV + 192 + 2 * jp), rkc = *(const LAS f32x2*)(CV + 256 + 2 * jp);
              f32x2 pe[12], e4[4], av4[4], rr4[4], kr4[4]; float inv4[4];
#pragma unroll
              for (int t = 0; t < 12; ++t) pe[t] = *(const LAS f32x2*)(E + (16 * sc + t) * FS + 2 * jp);
#pragma unroll
              for (int q = 0; q < 4; ++q) { const int n = 16 * sc + 4 * tq + q, of = n * FS + 2 * jp;
                  e4[q] = *(const LAS f32x2*)(E + of); av4[q] = *(const LAS f32x2*)(BB + of); rr4[q] = *(const LAS f32x2*)(R + of); kr4[q] = *(const LAS f32x2*)(KD + of); inv4[q] = INV[n]; }
              __builtin_amdgcn_sched_barrier(0);
#pragma unroll
              for (int t = 0; t < 12; ++t) { if (t < 4 * tq) lw += pe[t]; }
              f32x2 Wc = {__expf(lw[0]), __expf(lw[1])};
#pragma unroll
              for (int q = 0; q < 4; ++q) { const int n = 16 * sc + 4 * tq + q, o = SWZ64(n, 2 * jp);
                  const f32x2 e = e4[q], av = av4[q], rr = rr4[q], kr = kr4[q]; const float inv = inv4[q];
                  const f32x2 kk = kr * kkc * inv, aa = -kk, bb = kk * av, kd = kr * ((av - 1.0f) * kac + 1.0f);
                  float bon = rr[0] * kd[0] * rkc[0] + rr[1] * kd[1] * rkc[1];
                  bon = red16(bon); bon += dpp_mov_rm<0x142, 0xA>(bon);
                  if (jp == 31) BONUS[n] = bon;
                  const f32x2 Wp = Wc; lw += e; Wc = (f32x2){__expf(lw[0]), __expf(lw[1])}; const f32x2 Wi = {__builtin_amdgcn_rcpf(Wc[0]), __builtin_amdgcn_rcpf(Wc[1])};
                  typedef __bf16 bf16x2_t __attribute__((ext_vector_type(2)));
                  *(LAS unsigned*)(ATb + o * 2) = __builtin_bit_cast(unsigned, __builtin_convertvector(aa * Wp, bf16x2_t)); *(LAS unsigned*)(BTb + o * 2) = __builtin_bit_cast(unsigned, __builtin_convertvector(bb * Wi, bf16x2_t));
                  *(LAS unsigned*)(RTb + o * 2) = __builtin_bit_cast(unsigned, __builtin_convertvector(rr * Wc, bf16x2_t)); *(LAS unsigned*)(KTb + o * 2) = __builtin_bit_cast(unsigned, __builtin_convertvector(kd * Wi, bf16x2_t)); }
              if (tq == 3) *(LAS f32x2*)(WL + sc * 64 + 2 * jp) = Wc; }
            SCAN_BAR();
            if (wave < 4) { const int sc = wave; const f32x4 Zf = {0.f, 0.f, 0.f, 0.f};
#define ROWFRAG8(base_, k2_) (*(const LAS bf16x8*)((base_) + SWZ64(16 * sc + fr, 32 * (k2_) + 8 * fq) * 2))
                bf16x8 fA[2], fB[2], fK[2], fR[2]; unsigned short ub[4][4], uk[4][4];
#pragma unroll
                for (int k2 = 0; k2 < 2; ++k2) { fA[k2] = ROWFRAG8(ATb, k2); fB[k2] = ROWFRAG8(BTb, k2); fK[k2] = ROWFRAG8(KTb, k2); fR[k2] = ROWFRAG8(RTb, k2); }
#pragma unroll
                for (int jt = 0; jt < 4; ++jt)
#pragma unroll
                    for (int q = 0; q < 4; ++q) { const int off = SWZ64(16 * sc + 4 * fq + q, 16 * jt + fr); ub[jt][q] = ((const LAS unsigned short*)BTb)[off]; uk[jt][q] = ((const LAS unsigned short*)KTb)[off]; }
                __builtin_amdgcn_sched_barrier(0);
                f32x4 Mab = Zf, MabT = Zf;
#pragma unroll
                for (int k2 = 0; k2 < 2; ++k2) { Mab = MFMA32(fB[k2], fA[k2], Mab); MabT = MFMA32(fA[k2], fB[k2], MabT); }
                f32x4 Tm, TT;
#pragma unroll
                for (int rg = 0; rg < 4; ++rg) { const int rr = 4 * fq + rg;
                    Mab[rg] = rr < fr ? Mab[rg] : 0.f; MabT[rg] = fr < rr ? MabT[rg] : 0.f;
                    const float id = rr == fr ? 1.f : 0.f; Tm[rg] = id + Mab[rg]; TT[rg] = id + MabT[rg]; }
                {   f32x4 Mp = Mab, MpT = MabT;
#pragma unroll
                    for (int itn = 0; itn < 3; ++itn) { const s16x4 cMp = cvt4(Mp), cMpT = cvt4(MpT);
                        const f32x4 Mn = MFMA16(cMpT, cMp, Zf), MnT = MFMA16(cMp, cMpT, Zf);
                        const s16x4 cMn = cvt4(Mn), cTTi = cvt4(TT);
                        const f32x4 Tn = MFMA16(cTTi, cMn, Tm), TnT = MFMA16(cMn, cTTi, TT);
                        Tm = Tn; TT = TnT; Mp = Mn; MpT = MnT; } }
                const s16x4 cT = cvt4(Tm), cTT = cvt4(TT);
                f32x4 MakT = Zf;
#pragma unroll
                for (int k2 = 0; k2 < 2; ++k2) MakT = MFMA32(fA[k2], fK[k2], MakT);
#pragma unroll
                for (int rg = 0; rg < 4; ++rg) { const int rr = 4 * fq + rg; MakT[rg] = fr < rr ? MakT[rg] : 0.f; }
                const f32x4 PT = MFMA16(cT, cvt4(MakT), Zf);
                const s16x4 cPT = cvt4(PT);
                f32x4 Mrb = Zf, Mrk = Zf;
#pragma unroll
                for (int k2 = 0; k2 < 2; ++k2) { Mrb = MFMA32(fB[k2], fR[k2], Mrb); Mrk = MFMA32(fK[k2], fR[k2], Mrk); }
#pragma unroll
                for (int rg = 0; rg < 4; ++rg) { const int rr = 4 * fq + rg; Mrb[rg] = rr <= fr ? Mrb[rg] : 0.f; Mrk[rg] = rr <= fr ? Mrk[rg] : 0.f; }
                const s16x4 cMrb = cvt4(Mrb);
                const f32x4 Nn = MFMA16(cPT, cMrb, Mrk), N2 = MFMA16(cTT, cMrb, Zf);
                LAS unsigned char* fo = FRG + (sc * 5) * 1024 + lane * 16;
                *(LAS bf16x8*)(fo) = pk8(cvt4(N2), cvt4(Nn));
#pragma unroll
                for (int jt = 0; jt < 4; ++jt) { s16x4 bfr; f32x4 kc;
#pragma unroll
                    for (int q = 0; q < 4; ++q) { bfr[q] = (short)ub[jt][q]; kc[q] = bflo((unsigned)uk[jt][q]); }
                    const f32x4 B2 = MFMA16(cTT, bfr, Zf), K2 = MFMA16(cPT, bfr, kc);
                    *(LAS bf16x8*)(fo + (1 + jt) * 1024) = pk8(cvt4(B2), cvt4(K2)); }
#undef ROWFRAG8
            } else if (chain == vcu) { const int item = (cc * 4 + (wave - 4)) * G + vcu; if (item < MOE_W_ITEMS) moe_weight_dma(a, item, lane, lds + 51200 + (wave - 4) * 8192); }
            LDS_WAIT(); __builtin_amdgcn_s_barrier(); asm volatile("" ::: "memory");
            if (cc + 1 < 68) SCAN_LOAD(cc + 1);
            if (wave < 4) { const int it = wave; const f32x4 Zf = {0.f, 0.f, 0.f, 0.f};
                struct COpsA { s16x4 a[4], r[4]; unsigned short v[4]; }; struct COpsB { bf16x8 f[5]; f32x4 w[4]; };
#define C_LOAD_A(O, sc_) do { \
    _Pragma("unroll") for (int c4 = 0; c4 < 4; ++c4) { O.a[c4] = *(const LAS s16x4*)(ATb + SWZ64(16 * (sc_) + fr, 16 * c4 + 4 * fq) * 2); O.r[c4] = *(const LAS s16x4*)(RTb + SWZ64(16 * (sc_) + fr, 16 * c4 + 4 * fq) * 2); } \
    _Pragma("unroll") for (int q = 0; q < 4; ++q) O.v[q] = VT[SWZV(16 * (sc_) + 4 * fq + q, 16 * it + fr)]; } while (0)
#define C_LOAD_B(O, sc_) do { \
    _Pragma("unroll") for (int k5 = 0; k5 < 5; ++k5) O.f[k5] = *(const LAS bf16x8*)(FRG + ((sc_) * 5 + k5) * 1024 + lane * 16); \
    _Pragma("unroll") for (int jt = 0; jt < 4; ++jt) O.w[jt] = *(const LAS f32x4*)(WL + (sc_) * 64 + 16 * jt + 4 * fq); } while (0)
                COpsA ca, na; C_LOAD_A(ca, 0);
#pragma unroll
                for (int sc = 0; sc < 4; ++sc) {
                    COpsB cb; C_LOAD_B(cb, sc);
                    __builtin_amdgcn_sched_barrier(0);
                    const bf16x8 bS01 = pk8(cvt4(ST[0]), cvt4(ST[1])), bS23 = pk8(cvt4(ST[2]), cvt4(ST[3]));
                    f32x4 XT = MFMA32(pk8(ca.a[0], ca.a[1]), bS01, Zf); XT = MFMA32(pk8(ca.a[2], ca.a[3]), bS23, XT);
                    f32x4 YT = MFMA32(pk8(ca.r[0], ca.r[1]), bS01, Zf); YT = MFMA32(pk8(ca.r[2], ca.r[3]), bS23, YT);
                    s16x4 Vf;
#pragma unroll
                    for (int q = 0; q < 4; ++q) Vf[q] = (short)ca.v[q];
                    __builtin_amdgcn_sched_barrier(0);
                    if (sc < 3) C_LOAD_A(na, sc + 1);
                    __builtin_amdgcn_sched_barrier(0);
                    const bf16x8 BX = pk8(cvt4(XT), Vf);
                    YT = MFMA32(cb.f[0], BX, YT);
#pragma unroll
                    for (int jt = 0; jt < 4; ++jt) { const f32x4 acc = MFMA32(cb.f[1 + jt], BX, ST[jt]); ST[jt] = acc * cb.w[jt]; }
                    { const unsigned y01 = pk2(YT[0], YT[1]), y23 = pk2(YT[2], YT[3]); LAS unsigned short* yp = Yb + SWZV(16 * sc + 4 * fq, 16 * it + fr);
                      yp[0] = (unsigned short)y01; yp[64] = (unsigned short)(y01 >> 16); yp[128] = (unsigned short)y23; yp[192] = (unsigned short)(y23 >> 16); }
                    __builtin_amdgcn_sched_barrier(0);
                    ca = na;
                }
#undef C_LOAD_A
#undef C_LOAD_B
            }

            SCAN_BAR();
            if (is_lat) { const int pp = tid >> 3, iq = seg; const u32x4 yw = *(const LAS u32x4*)(Yb + SWZV(pp, 8 * iq));
                const u32x4 vw = *(const LAS u32x4*)(VT + SWZV(pp, 8 * iq)); const float bon = BONUS[pp];
                const f32x4 gg0 = *(const LAS f32x4*)(CV + 320 + 8 * iq), gg1 = *(const LAS f32x4*)(CV + 324 + 8 * iq), gb0 = *(const LAS f32x4*)(CV + 384 + 8 * iq), gb1 = *(const LAS f32x4*)(CV + 388 + 8 * iq);
                __builtin_amdgcn_sched_barrier(0);
                float y[8]; unpack8(yw, y); float s = 0.f;
#pragma unroll
                for (int q = 0; q < 8; ++q) s += y[q];
                const float mean = red8(s) * (1.0f / 64.0f); float qq = 0.f;
#pragma unroll
                for (int q = 0; q < 8; ++q) { y[q] -= mean; qq += y[q] * y[q]; }
                const float rstd = frsq(red8(qq) * (1.0f / 64.0f) + GN_EPS); float o[8];
                float vv[8]; unpack8(vw, vv);
#pragma unroll
                for (int q = 0; q < 8; ++q) { const float gq = q < 4 ? gg0[q & 3] : gg1[q & 3], bq_ = q < 4 ? gb0[q & 3] : gb1[q & 3]; o[q] = y[q] * rstd * gq + bq_ + bon * vv[q]; }
                u32x4 w; w.x = pk2(o[0], o[1]); w.y = pk2(o[2], o[3]); w.z = pk2(o[4], o[5]); w.w = pk2(o[6], o[7]);
                *(GAS u32x4*)(Z + ((size_t)d * ML + row0 + (d ? 63 - pp : pp)) * 512 + h * 64 + 8 * iq) = w; }
        }
        __syncthreads();
#undef SCAN_ROW0
#undef SCAN_BAR
#undef SCAN_LOAD
    }
}

template <int MTL>
__device__ __forceinline__ void dft_item(LAS unsigned char* lds, const bf16_t* src0, size_t src_stride, const bf16_t* Mat, bf16_t* dst0, size_t dst_stride, const float* bias, int wave, int lane) {
    constexpr int RS = 1032;
    const int fr = lane & 15, fq = lane >> 4;
    { u32x4 v[16];
#pragma unroll
      for (int rr = 0; rr < 16; ++rr) { const int k = wave * 16 + rr, ri = k >> 6, idx = k & 63; v[rr] = *(const u32x4*)(src0 + (size_t)idx * src_stride + ri * 512 + lane * 8); }
#pragma unroll
      for (int rr = 0; rr < 16; ++rr) { const int k = wave * 16 + rr; LAS unsigned char* p = lds + k * RS + lane * 16; *(LAS u32x2*)p = (u32x2){v[rr].x, v[rr].y}; *(LAS u32x2*)(p + 8) = (u32x2){v[rr].z, v[rr].w}; } }
    __syncthreads();
    const int n0 = wave * 64;
#pragma unroll 1
    for (int mp = 0; mp < MTL / 4; ++mp) {
        f32x4 acc[4][4];
#pragma unroll
        for (int m = 0; m < 4; ++m)
#pragma unroll
            for (int n = 0; n < 4; ++n) acc[m][n] = (f32x4){0.f, 0.f, 0.f, 0.f};
#pragma unroll 1
        for (int ks = 0; ks < 4; ++ks) {
            bf16x8 Bfr[4];
#pragma unroll
            for (int nt = 0; nt < 4; ++nt)
#pragma unroll
                for (int jj = 0; jj < 8; ++jj) Bfr[nt][jj] = (short)*(const LAS unsigned short*)(lds + (32 * ks + 8 * fq + jj) * RS + (n0 + 16 * nt + fr) * 2);
#pragma unroll
            for (int m = 0; m < 4; ++m) { const bf16x8 Af = *(const bf16x8*)(Mat + (size_t)(64 * mp + 16 * m + fr) * 128 + 32 * ks + 8 * fq);
#pragma unroll
                for (int nt = 0; nt < 4; ++nt) acc[m][nt] = __builtin_amdgcn_mfma_f32_16x16x32_bf16(Af, Bfr[nt], acc[m][nt], 0, 0, 0); }
        }
#pragma unroll
        for (int m = 0; m < 4; ++m)
#pragma unroll
            for (int nt = 0; nt < 4; ++nt) { const int n = n0 + 16 * nt + fr; const float bv = bias ? bias[n] : 0.f;
#pragma unroll
                for (int rg = 0; rg < 4; ++rg) { const int mm = 16 * m + 4 * fq + rg; dst0[(size_t)mm * dst_stride + mp * 512 + n] = (bf16_t)f2bf(acc[m][nt][rg] + bv); } }
    }
    __syncthreads();
}
__device__ __forceinline__ void phase4_f1(const Args& a, LAS unsigned char* lds, int vcu, int G, int wave, int lane) {
    const bf16_t* PF = (const bf16_t*)(a.ws + WS_PF); bf16_t* Z1 = (bf16_t*)(a.ws + WS_Z1); const bf16_t* M1 = (const bf16_t*)(a.ws + WS_MAT1);
    for (int it = vcu; it < 1024; it += G) { const int b = it >> 6, t2 = it & 63;
        dft_item<8>(lds, PF + ((size_t)b * 4096 + t2) * 1024, (size_t)64 * 1024, M1, Z1 + ((size_t)b * 4096 + t2) * 1024, (size_t)64 * 1024, nullptr, wave, lane); }
}
__device__ __forceinline__ void phase5_f2(const Args& a, LAS unsigned char* lds, int vcu, int G, int wave, int lane) {
    const bf16_t* Z1 = (const bf16_t*)(a.ws + WS_Z1); bf16_t* MIX = (bf16_t*)(a.ws + WS_MIX); const bf16_t* M2 = (const bf16_t*)(a.ws + WS_MAT2);
    for (int it = vcu; it < 1024; it += G) { const int b = it >> 6, t1p = it & 63;
        dft_item<4>(lds, Z1 + ((size_t)b * 4096 + t1p * 64) * 1024, (size_t)1024, M2 + (size_t)t1p * 64 * 128, MIX + ((size_t)b * 4096 + t1p) * 1024 + 512, (size_t)64 * 1024, a.in[I_BFNO], wave, lane); }
}

#define P7_LOAD(xd, md, row) do { const float* _xr = a.in[I_X] + (size_t)(row) * D; \
    _Pragma("unroll") for (int j = 0; j < 4; ++j) { xd[j] = __builtin_nontemporal_load((const f32x4*)(_xr + 4 * lane + 256 * j)); md[j] = __builtin_nontemporal_load((const u32x2*)(MO + (size_t)(row) * D + 4 * lane + 256 * j)); } } while (0)
template <bool COUNT> __device__ __forceinline__ void phase7(const Args& a, LAS unsigned char* lds, int vcu, int G, int tid, int wave, int lane) {
    const float* MOD = (const float*)(a.ws + WS_MOD); const bf16_t* MO = (const bf16_t*)(a.ws + WS_MO); bf16_t* X1 = (bf16_t*)(a.ws + WS_X1); unsigned char* H2 = a.ws + WS_H2;
    int* TOPI = (int*)(a.ws + WS_TOPI); float* TOPG = (float*)(a.ws + WS_TOPG); unsigned* CTL = (unsigned*)(a.ws + WS_CTL);
    constexpr int HRS = 2064;
    LAS unsigned char* HI = lds; LAS unsigned char* LO = lds + 16 * HRS; LAS float* PART = (LAS float*)(lds + 2 * 16 * HRS);
    LAS int* hist = (LAS int*)(lds + 2 * 16 * HRS + 16384);
    const int fr = lane & 15, fq = lane >> 4;
    bf16x8 Bh[2][4], Bl[2][4];
#pragma unroll
    for (int nt = 0; nt < 2; ++nt)
#pragma unroll
        for (int ks = 0; ks < 4; ++ks)
#pragma unroll
            for (int jj = 0; jj < 8; ++jj) { const float w = a.in[I_WR][(size_t)(128 * wave + 32 * ks + 8 * fq + jj) * 32 + 16 * nt + fr]; const unsigned h = f2bf(w); Bh[nt][ks][jj] = (short)h; Bl[nt][ks][jj] = (short)f2bf(w - bflo(h)); }
    if (tid < 64) hist[tid] = 0;
    const float brl = a.in[I_BR][lane & 31];
    const int TPW = (ML / 16 + G - 1) / G; const int tl0 = vcu * TPW; const int mrw = (tl0 * 16) >> 12;
    LAS float* PV = (LAS float*)(lds + 2 * 16 * HRS + 16384 + 256);
    for (int idx = tid; idx < 1024; idx += 512) { PV[idx] = a.in[I_LN0G][idx]; PV[1024 + idx] = a.in[I_LN0B][idx]; PV[2048 + idx] = MOD[mrw * 6144 + 2048 + idx];
        PV[3072 + idx] = a.in[I_LN1G][idx]; PV[4096 + idx] = a.in[I_LN1B][idx]; PV[5120 + idx] = MOD[mrw * 6144 + 3072 + idx]; PV[6144 + idx] = MOD[mrw * 6144 + 4096 + idx]; }
    __syncthreads();
    f32x4 va[4], vb[4]; u32x2 ma[4], mb[4];
    int tl = tl0; const int tlend = (tl0 + TPW < ML / 16) ? tl0 + TPW : ML / 16;
    if (tl < tlend) { P7_LOAD(va, ma, tl * 16 + 2 * wave); P7_LOAD(vb, mb, tl * 16 + 2 * wave + 1); }
    for (; tl < tlend; ++tl) {
        const int row0 = tl * 16, ra = row0 + 2 * wave;
        float sa = 0.f, sb = 0.f;
#pragma unroll
        for (int j = 0; j < 4; ++j) { sa += (va[j][0] + va[j][1]) + (va[j][2] + va[j][3]); sb += (vb[j][0] + vb[j][1]) + (vb[j][2] + vb[j][3]); }
        float m1 = wave_sum(sa) * (1.f / D), m2 = wave_sum(sb) * (1.f / D); float qa = 0.f, qb = 0.f;
#pragma unroll
        for (int j = 0; j < 4; ++j) { va[j] = va[j] - m1; vb[j] = vb[j] - m2;
            qa += (va[j][0] * va[j][0] + va[j][1] * va[j][1]) + (va[j][2] * va[j][2] + va[j][3] * va[j][3]); qb += (vb[j][0] * vb[j][0] + vb[j][1] * vb[j][1]) + (vb[j][2] * vb[j][2] + vb[j][3] * vb[j][3]); }
        float r1 = frsq(wave_sum(qa) * (1.f / D) + LN_EPS), r2 = frsq(wave_sum(qb) * (1.f / D) + LN_EPS);
        sa = 0.f; sb = 0.f;
#pragma unroll
        for (int j = 0; j < 4; ++j) { const int c = 4 * lane + 256 * j;
            const f32x4 g = *(const LAS f32x4*)(PV + c), b = *(const LAS f32x4*)(PV + 1024 + c), gt = *(const LAS f32x4*)(PV + 2048 + c);
            const f32x4 moa = {bflo(ma[j].x), bfhi(ma[j].x), bflo(ma[j].y), bfhi(ma[j].y)}, mob = {bflo(mb[j].x), bfhi(mb[j].x), bflo(mb[j].y), bfhi(mb[j].y)};
            va[j] = (va[j] * r1 * g + b) * DN_ALPHA + gt * moa; vb[j] = (vb[j] * r2 * g + b) * DN_ALPHA + gt * mob;
            sa += (va[j][0] + va[j][1]) + (va[j][2] + va[j][3]); sb += (vb[j][0] + vb[j][1]) + (vb[j][2] + vb[j][3]); }
        m1 = wave_sum(sa) * (1.f / D); m2 = wave_sum(sb) * (1.f / D); qa = 0.f; qb = 0.f;
#pragma unroll
        for (int j = 0; j < 4; ++j) { va[j] = va[j] - m1; vb[j] = vb[j] - m2;
            qa += (va[j][0] * va[j][0] + va[j][1] * va[j][1]) + (va[j][2] * va[j][2] + va[j][3] * va[j][3]); qb += (vb[j][0] * vb[j][0] + vb[j][1] * vb[j][1]) + (vb[j][2] * vb[j][2] + vb[j][3] * vb[j][3]); }
        r1 = frsq(wave_sum(qa) * (1.f / D) + LN_EPS); r2 = frsq(wave_sum(qb) * (1.f / D) + LN_EPS);
#pragma unroll
        for (int j = 0; j < 4; ++j) { const int c = 4 * lane + 256 * j;
            const f32x4 g = *(const LAS f32x4*)(PV + 3072 + c), b = *(const LAS f32x4*)(PV + 4096 + c), sh = *(const LAS f32x4*)(PV + 5120 + c), sc = *(const LAS f32x4*)(PV + 6144 + c);
#pragma unroll
            for (int q = 0; q < 2; ++q) { const f32x4 x1 = (q ? vb[j] * r2 : va[j] * r1) * g + b; const int row = ra + q;
                u32x2 o; o.x = pk2(x1[0], x1[1]); o.y = pk2(x1[2], x1[3]); *(GAS u32x2*)(X1 + (size_t)row * D + c) = o;
                const f32x4 h = x1 * (sc + 1.0f) + sh;
                { unsigned w8 = 0u; w8 = __builtin_amdgcn_cvt_pk_fp8_f32(h[0], h[1], w8, false); w8 = __builtin_amdgcn_cvt_pk_fp8_f32(h[2], h[3], w8, true); *(GAS unsigned*)(H2 + (size_t)row * D + c) = w8; }
                u32x2 hw; hw.x = pk2(h[0], h[1]); hw.y = pk2(h[2], h[3]);
                u32x2 lw; lw.x = pk2(h[0] - bflo(hw.x), h[1] - bfhi(hw.x)); lw.y = pk2(h[2] - bflo(hw.y), h[3] - bfhi(hw.y));
                *(LAS u32x2*)(HI + (2 * wave + q) * HRS + c * 2) = hw; *(LAS u32x2*)(LO + (2 * wave + q) * HRS + c * 2) = lw; } }
        asm volatile("" ::: "memory");
        if (tl + 1 < tlend) { P7_LOAD(va, ma, (tl + 1) * 16 + 2 * wave); P7_LOAD(vb, mb, (tl + 1) * 16 + 2 * wave + 1); }
        __syncthreads();
        { f32x4 acc[2] = {{0.f, 0.f, 0.f, 0.f}, {0.f, 0.f, 0.f, 0.f}};
#pragma unroll
          for (int ks = 0; ks < 4; ++ks) { const bf16x8 ah = *(const LAS bf16x8*)(HI + fr * HRS + (128 * wave + 32 * ks + 8 * fq) * 2), al = *(const LAS bf16x8*)(LO + fr * HRS + (128 * wave + 32 * ks + 8 * fq) * 2);
#pragma unroll
              for (int nt = 0; nt < 2; ++nt) { acc[nt] = __builtin_amdgcn_mfma_f32_16x16x32_bf16(ah, Bh[nt][ks], acc[nt], 0, 0, 0); acc[nt] = __builtin_amdgcn_mfma_f32_16x16x32_bf16(ah, Bl[nt][ks], acc[nt], 0, 0, 0); acc[nt] = __builtin_amdgcn_mfma_f32_16x16x32_bf16(al, Bh[nt][ks], acc[nt], 0, 0, 0); } }
#pragma unroll
          for (int nt = 0; nt < 2; ++nt)
#pragma unroll
              for (int rg = 0; rg < 4; ++rg) PART[(wave * 16 + 4 * fq + rg) * 32 + 16 * nt + fr] = acc[nt][rg]; }
        __syncthreads();
        { const int e = lane & 31, rr = lane >> 5; float lg = brl;
#pragma unroll
          for (int w = 0; w < 8; ++w) lg += PART[(w * 16 + 2 * wave + rr) * 32 + e];
          int ti[4]; float tv[4];
#pragma unroll
          for (int k = 0; k < 4; ++k) { float m = lg;
              m = fmaxf(m, dpp_mov<0xB1>(m)); m = fmaxf(m, dpp_mov<0x4E>(m)); m = fmaxf(m, dpp_mov<0x141>(m)); m = fmaxf(m, dpp_mov<0x140>(m));
              { const float up = __builtin_bit_cast(float, __builtin_amdgcn_update_dpp(__builtin_bit_cast(int, m), __builtin_bit_cast(int, m), 0x142, 0xA, 0xF, false)); m = fmaxf(m, up); }
              const float mlo = __builtin_bit_cast(float, __builtin_amdgcn_readlane(__builtin_bit_cast(int, m), 31)), mhi = __builtin_bit_cast(float, __builtin_amdgcn_readlane(__builtin_bit_cast(int, m), 63));
              const float mm = rr ? mhi : mlo;
              const unsigned long long bal = __ballot(lg == mm); const unsigned bl = (unsigned)bal, bh = (unsigned)(bal >> 32);
              const int ilo = bl ? __ffs((int)bl) - 1 : k, ihi = bh ? __ffs((int)bh) - 1 : k;
              const int idx = rr ? ihi : ilo;
              ti[k] = idx; tv[k] = mm; if (e == idx) lg = -3.0e38f; }
          const float e1 = __expf(tv[1] - tv[0]), e2 = __expf(tv[2] - tv[0]), e3 = __expf(tv[3] - tv[0]); const float inv = frcp(1.0f + e1 + e2 + e3);
          if (e == 0) { const int row = ra + rr; *(GAS i32x4*)(TOPI + (size_t)row * 4) = (i32x4){ti[0], ti[1], ti[2], ti[3]}; *(GAS f32x4*)(TOPG + (size_t)row * 4) = (f32x4){inv, e1 * inv, e2 * inv, e3 * inv};
              const int hb = 0;
#pragma unroll
              for (int k = 0; k < 4; ++k) __hip_atomic_fetch_add(hist + hb + ti[k], 1, __ATOMIC_RELAXED, __HIP_MEMORY_SCOPE_WORKGROUP); } }
    }
    __syncthreads();
    if (COUNT && tid < 32) { const int hv = hist[tid]; if (hv) __hip_atomic_fetch_add(CTL + CW_CNT + tid, (unsigned)hv, RLX_AGENT); }
    __syncthreads();
}
#undef P7_LOAD

__device__ __forceinline__ void phase8(const Args& a, LAS unsigned char* lds, int vcu, int G, int tid) {
    unsigned* CTL = (unsigned*)(a.ws + WS_CTL); const int* TOPI = (const int*)(a.ws + WS_TOPI); int* TOKSLOT = (int*)(a.ws + WS_TOKSLOT); int* SLOTTOK = (int*)(a.ws + WS_SLOTTOK); int* TILEE = (int*)(a.ws + WS_TILEE);
    LAS int* pstart = (LAS int*)lds;
    LAS int* lh = pstart + 64;
    LAS int* lbase = lh + 32;
    LAS int* cnts = lbase + 32;
    if (tid < 32) cnts[tid] = (int)__hip_atomic_load(CTL + CW_CNT + tid, RLX_AGENT);
    __syncthreads();
    if (tid == 0) { int p = 0; for (int e = 0; e < 32; ++e) { pstart[e] = p; p += (cnts[e] + 255) & ~255; } }
    __syncthreads();
    if (vcu == 0) {
        const int tot = pstart[31] + ((cnts[31] + 255) & ~255);
        if (tid == 0) CTL[CW_NT] = (unsigned)(tot >> 8);
        for (int tl = tid; tl < (tot >> 8); tl += 512) { int e = 0;
            for (int q = 1; q < 32; ++q) if (pstart[q] <= tl * 256) e = q;
            TILEE[tl] = e; }
        for (int e = 0; e < 32; ++e) { const int lo = pstart[e] + cnts[e], hi = pstart[e] + ((cnts[e] + 255) & ~255);
            for (int sl = lo + tid; sl < hi; sl += 512) SLOTTOK[sl] = 0; }
    }
    for (int rt = vcu; rt < 256; rt += G) {
        __syncthreads();
        if (tid < 32) lh[tid] = 0;
        __syncthreads();
        int e2[2], lp[2];
#pragma unroll
        for (int z = 0; z < 2; ++z) { const int p = tid * 2 + z; e2[z] = TOPI[(size_t)rt * 1024 + p]; lp[z] = __hip_atomic_fetch_add(lh + e2[z], 1, __ATOMIC_RELAXED, __HIP_MEMORY_SCOPE_WORKGROUP); }
        __syncthreads();
        if (tid < 32) { const int c = lh[tid]; int base = 0; if (c) base = (int)__hip_atomic_fetch_add(CTL + CW_CUR + tid, (unsigned)c, RLX_AGENT); lbase[tid] = pstart[tid] + base; }
        __syncthreads();
#pragma unroll
        for (int z = 0; z < 2; ++z) { const int p = tid * 2 + z; const int slot = lbase[e2[z]] + lp[z]; TOKSLOT[(size_t)rt * 1024 + p] = slot; SLOTTOK[slot] = rt * 256 + (p >> 2); }
    }
}

#define PC_YLOAD(yd, xd, sl, row) do { _Pragma("unroll") for (int k = 0; k < 4; ++k) { const unsigned char* _yr = Yb + (size_t)(sl)[k] * 1024; \
        _Pragma("unroll") for (int j = 0; j < 4; ++j) yd[k][j] = *(const unsigned*)(_yr + 4 * lane + 256 * j); } \
    _Pragma("unroll") for (int j = 0; j < 4; ++j) xd[j] = __builtin_nontemporal_load((const u32x2*)(X1 + (size_t)(row) * D + 4 * lane + 256 * j)); } while (0)
__device__ __forceinline__ void phase_combine(const Args& a, int vcu, int G, int wave, int lane) {
    constexpr int hh = 0, HROWS = ML;
    const float* MOD = (const float*)(a.ws + WS_MOD); const bf16_t* X1 = (const bf16_t*)(a.ws + WS_X1); const unsigned char* Yb = a.ws + WS_Y;
    const int* TOKSLOT = (const int*)(a.ws + WS_TOKSLOT); const float* TOPG = (const float*)(a.ws + WS_TOPG);
    const int gw = vcu * 8 + wave, NGW = G * 8;
    f32x4 g2[4], b2[4];
#pragma unroll
    for (int j = 0; j < 4; ++j) { g2[j] = *(const f32x4*)(a.in[I_LN2G] + 4 * lane + 256 * j); b2[j] = *(const f32x4*)(a.in[I_LN2B] + 4 * lane + 256 * j); }
    int rr = gw; if (rr >= HROWS) return;
    i32x4 sl0 = *(const i32x4*)(TOKSLOT + (size_t)(hh * HROWS + rr) * 4); f32x4 gg0 = *(const f32x4*)(TOPG + (size_t)(hh * HROWS + rr) * 4);
    unsigned y0[4][4]; u32x2 x0[4];
    PC_YLOAD(y0, x0, sl0, hh * HROWS + rr);
    i32x4 sl1 = sl0; f32x4 gg1 = gg0;
    if (rr + NGW < HROWS) { sl1 = *(const i32x4*)(TOKSLOT + (size_t)(hh * HROWS + rr + NGW) * 4); gg1 = *(const f32x4*)(TOPG + (size_t)(hh * HROWS + rr + NGW) * 4); }
    for (; rr < HROWS; rr += NGW) { const int row = hh * HROWS + rr, mr = row >> 12;
        unsigned y1[4][4]; u32x2 x1n[4]; i32x4 sl2 = sl1; f32x4 gg2 = gg1; f32x4 gtv[4];
#pragma unroll
        for (int j = 0; j < 4; ++j) gtv[j] = *(const f32x4*)(MOD + mr * 6144 + 5120 + 4 * lane + 256 * j);
        asm volatile("" ::: "memory");
        if (rr + NGW < HROWS) { PC_YLOAD(y1, x1n, sl1, row + NGW); }
        if (rr + 2 * NGW < HROWS) { sl2 = *(const i32x4*)(TOKSLOT + (size_t)(row + 2 * NGW) * 4); gg2 = *(const f32x4*)(TOPG + (size_t)(row + 2 * NGW) * 4); }
        f32x4 v[4]; float s = 0.f;
#pragma unroll
        for (int j = 0; j < 4; ++j) { const int c = 4 * lane + 256 * j; f32x4 f = {0.f, 0.f, 0.f, 0.f};
#pragma unroll
            for (int k = 0; k < 4; ++k) { const f32x2 ylo = __builtin_amdgcn_cvt_pk_f32_fp8(y0[k][j], false), yhi = __builtin_amdgcn_cvt_pk_f32_fp8(y0[k][j], true); f += (f32x4){ylo[0], ylo[1], yhi[0], yhi[1]} * gg0[k]; }
            const f32x4 gt = gtv[j];
            v[j] = (f32x4){bflo(x0[j].x), bfhi(x0[j].x), bflo(x0[j].y), bfhi(x0[j].y)} * DN_ALPHA + gt * f; s += (v[j][0] + v[j][1]) + (v[j][2] + v[j][3]); }
        const float mean = wave_sum(s) * (1.f / D); float s2 = 0.f;
#pragma unroll
        for (int j = 0; j < 4; ++j) { v[j] = v[j] - mean; s2 += (v[j][0] * v[j][0] + v[j][1] * v[j][1]) + (v[j][2] * v[j][2] + v[j][3] * v[j][3]); }
        const float rstd = frsq(wave_sum(s2) * (1.f / D) + LN_EPS);
#pragma unroll
        for (int j = 0; j < 4; ++j) { const int c = 4 * lane + 256 * j; __builtin_nontemporal_store(v[j] * rstd * g2[j] + b2[j], (f32x4*)(a.out + (size_t)row * D + c)); }
#pragma unroll
        for (int k = 0; k < 4; ++k)
#pragma unroll
            for (int j = 0; j < 4; ++j) y0[k][j] = y1[k][j];
#pragma unroll
        for (int j = 0; j < 4; ++j) x0[j] = x1n[j];
        gg0 = gg1; sl1 = sl2; gg1 = gg2;
    }
}
#undef PC_YLOAD
#ifndef MK_N_LAUNCHES
#define MK_N_LAUNCHES 1
#endif
constexpr int NPH = 12;
__global__ void __launch_bounds__(512, 2) fwd_kernel(Args args) {
    extern __shared__ __attribute__((aligned(16))) unsigned char lds_raw[];
    LAS unsigned char* lds = (LAS unsigned char*)lds_raw;
    volatile LAS unsigned* MISC = (volatile LAS unsigned*)(lds + MISC_OFF);
    const int tid = threadIdx.x, lane = tid & 63, wave = __builtin_amdgcn_readfirstlane(tid >> 6);
    const int G = gridDim.x; const int bx = blockIdx.x; const int vcu = (G % 8 == 0) ? (bx % 8) * (G / 8) + bx / 8 : bx;
    unsigned char* ws = args.ws; unsigned* CTL = (unsigned*)(ws + WS_CTL);
    if (tid < 64) MISC[tid] = 0u;
    __syncthreads();
    const int lo = args.ph_lo, hi = args.ph_hi;
    XcdBarrier bar; bar.bar = CTL + CW_BAR; bar.x = 0; bar.st = nullptr;
    if (hi - lo > 1) bar = xcd_barrier_post(CTL + CW_BAR, MISC + 8);
#ifdef PH_ONLY
#define IN(k) ((k) == PH_ONLY && lo <= (k) && (k) < hi)
#else
#define IN(k) (lo <= (k) && (k) < hi)
#endif
#define SEAM(k) do { if (IN(k) && IN((k) + 1)) xcd_barrier(bar); } while (0)

    if (IN(0)) {
        phase0(args, lds, vcu, G, tid, wave, lane);
    }
    SEAM(0);
    if (IN(1)) {
        phase1(args, vcu, G, wave, lane);
    }
    SEAM(1);
    if (IN(2)) {
        { pg8::Gemm g{ws + WS_H, ws + WS_WINT, 2048, 2048, nullptr};
          SchedInProj S; S.init(G, bx);
          EpiInProj E{(bf16_t*)(ws + WS_PS), (bf16_t*)(ws + WS_PF)};
          pg8::gemm_phase<EpiInProj, SchedInProj, false, false>(lds, g, S, E); }
    }
    SEAM(2);
    if (IN(3)) {
        phase3_shift(args, vcu, G, tid);
    }
    SEAM(3);
    if (IN(4)) {
        phase4_scan(args, lds, vcu, G, tid, wave, lane);
        phase4_f1(args, lds, vcu, G, wave, lane);
    }
    SEAM(4);
    if (IN(5)) {
        { pg8::Gemm g{ws + WS_MS + 1792 * 2, ws + WS_GATEBT, 4096, 512, nullptr};
          SchedGrid S; S.init(ML / 256, 4, G, bx);
          EpiGate E{(const bf16_t*)(ws + WS_Z), (bf16_t*)(ws + WS_MIX)};
          pg8::gemm_phase<EpiGate, SchedGrid, false, false>(lds, g, S, E); }
        __syncthreads();
        phase5_f2(args, lds, vcu, G, wave, lane);
    }
    SEAM(5);
    if (IN(6)) {
        { pg8::Gemm g{ws + WS_MIX, ws + WS_WOUTT, 2048, 2048, nullptr};
          SchedGrid S; S.init(ML / 256, 4, G, bx);
          EpiBf16Plain E{(bf16_t*)(ws + WS_MO), 1024};
          pg8::gemm_phase<EpiBf16Plain, SchedGrid, false, false>(lds, g, S, E); }
    }
    SEAM(6);
    if (IN(7)) {
        phase7<true>(args, lds, vcu, G, tid, wave, lane);
    }
    SEAM(7);
    if (IN(8)) { phase8(args, lds, vcu, G, tid); }
    SEAM(8);
    if (IN(9)) {
        LAS int* te = (LAS int*)(lds + RING_BYTES); const int ntl = (int)__hip_atomic_load(CTL + CW_NT, RLX_AGENT);
        for (int q = tid; q < ntl; q += 512) te[q] = ((const int*)(ws + WS_TILEE))[q];
        __syncthreads();
        { pg8::Gemm g{ws + WS_H2, (unsigned char*)args.out + OUT_W1T, 1024, 1024, (const int*)(ws + WS_SLOTTOK)};
          SchedMoE S{G, bx, 8, ntl, te, false};
          EpiSwiGLU E{(unsigned char*)(ws + WS_ACT), args.in[I_B1]};
          pg8::gemm_phase<EpiSwiGLU, SchedMoE, true, true>(lds, g, S, E); }
    }
    SEAM(9);
    if (IN(10)) {
        LAS int* te = (LAS int*)(lds + RING_BYTES); const int ntl = (int)__hip_atomic_load(CTL + CW_NT, RLX_AGENT);
        for (int q = tid; q < ntl; q += 512) te[q] = ((const int*)(ws + WS_TILEE))[q];
        __syncthreads();
        { pg8::Gemm g{ws + WS_ACT, ws + WS_W2T, 1024, 1024, nullptr};
          SchedMoE S{G, bx, 4, ntl, te, true};
          EpiY E{ws + WS_Y, args.in[I_B2]};
          pg8::gemm_phase<EpiY, SchedMoE, false, true>(lds, g, S, E); }
    }
    SEAM(10);
    if (IN(11)) {
        phase_combine(args, vcu, G, wave, lane);
    }
#undef IN
#undef SEAM
}

extern "C" void kernel_launch(void* const* d_in, const int* in_sizes, int n_in, void* d_out, int out_size, void* d_ws, size_t ws_size, hipStream_t stream) {
    static int grid = 0;
    if (grid == 0) {
        if (n_in != 33 || out_size != ML * D || ws_size < WS_END) { fprintf(stderr, "kernel_launch: unexpected shapes (n_in %d, out %d, ws %zu); nothing launched\n", n_in, out_size, ws_size); grid = -1; return; }
        int dev = 0, cus = 0, per_cu = 0;
        if (hipGetDevice(&dev) != hipSuccess || hipDeviceGetAttribute(&cus, hipDeviceAttributeMultiprocessorCount, dev) != hipSuccess) { grid = -1; return; }
        if (hipFuncSetAttribute((const void*)fwd_kernel, hipFuncAttributeMaxDynamicSharedMemorySize, LDS_BYTES) != hipSuccess) { fprintf(stderr, "kernel_launch: hipFuncSetAttribute failed\n"); grid = -1; return; }
        if (hipOccupancyMaxActiveBlocksPerMultiprocessor(&per_cu, (const void*)fwd_kernel, 512, LDS_BYTES) != hipSuccess || per_cu < 1) { fprintf(stderr, "kernel_launch: occupancy query says %d\n", per_cu); }
        (void)hipGetLastError();
        grid = cus;
    }
    if (grid < 0) return;
    if (hipMemsetAsync((char*)d_ws + WS_CTL, 0, CTL_ZERO_BYTES, stream) != hipSuccess) return;
    Args a{};
    for (int i = 0; i < 33; ++i) a.in[i] = (const float*)d_in[i];
    a.out = (float*)d_out; a.ws = (unsigned char*)d_ws;
#if MK_N_LAUNCHES == 1
    a.ph_lo = 0; a.ph_hi = NPH;
    hipLaunchKernelGGL(fwd_kernel, dim3(grid), dim3(512), LDS_BYTES, stream, a);
#else
    for (int p = 0; p < NPH; ++p) { a.ph_lo = p; a.ph_hi = p + 1; hipLaunchKernelGGL(fwd_kernel, dim3(grid), dim3(512), LDS_BYTES, stream, a); }
#endif
}
```

```cpp
#include <hip/hip_runtime.h>
#include <cstdio>
#include <cstdint>

#define GAS __attribute__((address_space(1)))
#define LAS __attribute__((address_space(3)))
typedef unsigned short bf16_t;
typedef short bf16x8 __attribute__((ext_vector_type(8)));
typedef float f32x4 __attribute__((ext_vector_type(4)));
typedef float f32x2 __attribute__((ext_vector_type(2)));
typedef unsigned u32x4 __attribute__((ext_vector_type(4)));
typedef unsigned u32x2 __attribute__((ext_vector_type(2)));
typedef int i32x4 __attribute__((ext_vector_type(4)));
typedef int i32x8 __attribute__((ext_vector_type(8)));
typedef GAS unsigned gu32;
#define RLX_AGENT __ATOMIC_RELAXED, __HIP_MEMORY_SCOPE_AGENT
#define LDS_WAIT() asm volatile("s_waitcnt lgkmcnt(0)" ::: "memory")
#define VM_WAIT() asm volatile("s_waitcnt vmcnt(0)" ::: "memory")

__device__ __forceinline__ unsigned f2bf(float f) { unsigned u = __builtin_bit_cast(unsigned, f); return (u + 0x7fffu + ((u >> 16) & 1u)) >> 16; }
typedef __bf16 bf16x2_t_ __attribute__((ext_vector_type(2)));
__device__ __forceinline__ unsigned pk2(float lo, float hi) { const f32x2 v = {lo, hi}; return __builtin_bit_cast(unsigned, __builtin_convertvector(v, bf16x2_t_)); }
__device__ __forceinline__ float bflo(unsigned w) { return __builtin_bit_cast(float, w << 16); }
__device__ __forceinline__ float bfhi(unsigned w) { return __builtin_bit_cast(float, w & 0xffff0000u); }
__device__ __forceinline__ float frcp(float x) { return __builtin_amdgcn_rcpf(x); }
__device__ __forceinline__ float frsq(float x) { return __builtin_amdgcn_rsqf(x); }
__device__ __forceinline__ float sigmoidf_(float x) { return frcp(1.0f + __expf(-x)); }

template <int CTRL> __device__ __forceinline__ float dpp_mov(float v) { return __builtin_bit_cast(float, __builtin_amdgcn_update_dpp(0, __builtin_bit_cast(int, v), CTRL, 0xF, 0xF, false)); }
__device__ __forceinline__ float red8(float v) { v += dpp_mov<0xB1>(v); v += dpp_mov<0x4E>(v); v += dpp_mov<0x141>(v); return v; }
__device__ __forceinline__ float red16(float v) { v = red8(v); v += dpp_mov<0x140>(v); return v; }
template <int CTRL, int RM> __device__ __forceinline__ float dpp_mov_rm(float v) { return __builtin_bit_cast(float, __builtin_amdgcn_update_dpp(0, __builtin_bit_cast(int, v), CTRL, RM, 0xF, false)); }
__device__ __forceinline__ float wave_sum(float v) {
    v = red16(v); v += dpp_mov_rm<0x142, 0xA>(v); v += dpp_mov_rm<0x143, 0xC>(v);
    return __builtin_bit_cast(float, __builtin_amdgcn_readlane(__builtin_bit_cast(int, v), 63));
}
__device__ __forceinline__ float wave_max(float v) {
    v = fmaxf(v, dpp_mov<0xB1>(v)); v = fmaxf(v, dpp_mov<0x4E>(v)); v = fmaxf(v, dpp_mov<0x141>(v)); v = fmaxf(v, dpp_mov<0x140>(v));
    v = fmaxf(v, __shfl_xor(v, 16)); v = fmaxf(v, __shfl_xor(v, 32));
    return v;
}

#define XB_TMO      128
#define XB_XCNT(j)  (256  + 64 * (j))
#define XB_XSUB(j)  (1280 + 64 * (j))
#define XB_XGEN(j)  (2304 + 64 * (j))
#define XB_TOP      3328
#define XB_TOPGEN   3392
#define XCD_BAR_WORDS 3456
#define XB_SPIN_CAP (1u << 18)
__device__ __forceinline__ unsigned xb_ld(unsigned* p)              { return __hip_atomic_load(p, __ATOMIC_RELAXED, __HIP_MEMORY_SCOPE_AGENT); }
__device__ __forceinline__ unsigned xb_add(unsigned* p, unsigned v) { return __hip_atomic_fetch_add(p, v, __ATOMIC_RELAXED, __HIP_MEMORY_SCOPE_AGENT); }
__device__ __forceinline__ unsigned xb_xcc_id() { return (unsigned)__builtin_amdgcn_s_getreg((3 << 11) | 20) & 0xFu; }
#define XB_SPIN(cond, bar) do { unsigned _sp = 0; while (cond) { __builtin_amdgcn_s_sleep(1); \
    if ((++_sp & 255u) == 0u) { if (xb_ld(&(bar)[XB_TMO])) break; if (_sp > XB_SPIN_CAP) { atomicAdd(&(bar)[XB_TMO], 1u); break; } } } } while (0)
struct XcdBarrier { unsigned* bar; unsigned x; volatile LAS unsigned* st; };
__device__ __forceinline__ XcdBarrier xcd_barrier_post(unsigned* bar, volatile LAS unsigned* st) {
    XcdBarrier b; b.bar = bar; b.x = xb_xcc_id(); b.st = st;
    if (threadIdx.x == 0) (void)xb_add(&bar[XB_XCNT(b.x)], 1u);
    return b;
}
__device__ __forceinline__ void xcd_barrier_complete(unsigned* bar, unsigned x, unsigned& nloc, unsigned& nx) {
    const unsigned G = gridDim.x * gridDim.y * gridDim.z;
    unsigned sum, cnt, mine, sp = 0u;
    for (;;) {
        sum = 0u; cnt = 0u; mine = 0u;
#pragma unroll
        for (unsigned j = 0; j < 16; ++j) { const unsigned c = xb_ld(&bar[XB_XCNT(j)]); sum += c; cnt += (c > 0u) ? 1u : 0u; mine = (j == x) ? c : mine; }
        if (sum == G) break;
        __builtin_amdgcn_s_sleep(1);
        if ((++sp & 255u) == 0u) { if (xb_ld(&bar[XB_TMO])) break; if (sp > XB_SPIN_CAP) { atomicAdd(&bar[XB_TMO], 1u); break; } }
    }
    nloc = mine > 0u ? mine : 1u; nx = cnt > 0u ? cnt : 1u;
}
__device__ __forceinline__ void xcd_barrier(const XcdBarrier& b) {
    asm volatile("s_waitcnt vmcnt(0)" ::: "memory");
    __syncthreads();
    if (threadIdx.x == 0) {
        unsigned* bar = b.bar;
        __builtin_amdgcn_s_waitcnt(0);
        unsigned nloc = b.st[0], nx = b.st[1];
        if (nloc == 0u) { xcd_barrier_complete(bar, b.x, nloc, nx); b.st[0] = nloc; b.st[1] = nx; }
        const unsigned old = xb_add(&bar[XB_XSUB(b.x)], 1u);
        const unsigned gen = old / nloc;
        if (old + 1u == (gen + 1u) * nloc) {
            __builtin_amdgcn_fence(__ATOMIC_RELEASE, "agent");
            asm volatile("s_waitcnt vmcnt(0)" ::: "memory");
            const unsigned og = xb_add(&bar[XB_TOP], 1u);
            const unsigned tg = og / nx;
            if (og + 1u == (tg + 1u) * nx) xb_add(&bar[XB_TOPGEN], 1u);
            else XB_SPIN(xb_ld(&bar[XB_TOPGEN]) == tg, bar);
            __builtin_amdgcn_fence(__ATOMIC_ACQUIRE, "agent");
            xb_add(&bar[XB_XGEN(b.x)], 1u);
            asm volatile("s_waitcnt vmcnt(0)" ::: "memory");
        } else {
            XB_SPIN(xb_ld(&bar[XB_XGEN(b.x)]) == gen, bar);
            __builtin_amdgcn_fence(__ATOMIC_ACQUIRE, "agent");
            asm volatile("s_waitcnt vmcnt(0)" ::: "memory");
        }
    }
    __syncthreads();
}

namespace pg8 {
constexpr int BM = 256, BK = 64, HALF = 128, HTB = HALF * BK * 2, STAGE_BYTES = 8 * HTB, NXCD = 8, WGM = 8;
__host__ __device__ __forceinline__ int lds_byte(int r, int c) { const int st = (r >> 4) * 2 + (c >> 5), rr = r & 15, cc = c & 31, ob = rr * 64 + cc * 2; return st * 1024 + (ob ^ (((ob >> 9) & 1) << 5)); }
__host__ __device__ __forceinline__ void stage_rc(int b, int& R, int& C) { const int st = b / 1024, sb = b % 1024, swz = sb ^ (((sb >> 9) & 1) << 5); R = (st >> 1) * 16 + swz / 64; C = (st & 1) * 32 + (swz % 64) / 2; }
__host__ __device__ __forceinline__ int perm32(int rho) { const int n = rho >> 4, i = rho & 15; return 8 * (i >> 2) + 4 * n + (i & 3); }

struct Unit { int pm, pn, pb; };
struct Gemm { const void* A; const void* Bt; int lda; int K; const int* gidx; };

__device__ __forceinline__ unsigned cvt_pk_bf16(float lo, float hi) { unsigned r; asm volatile("v_cvt_pk_bf16_f32 %0, %1, %2" : "=v"(r) : "v"(lo), "v"(hi)); return r; }

template <class Epi, class Sched, bool GATHER, bool FP8>
__device__ __forceinline__ void gemm_phase(LAS unsigned char* lds, const Gemm g, const Sched& S, const Epi& E) {
    const int tid = threadIdx.x, wid = __builtin_amdgcn_readfirstlane(tid >> 6), lane = tid & 63, wr = wid >> 2, wc = wid & 3, fr = lane & 15, fq = lane >> 4;
    const int K = g.K, nt = K / 128;
    unsigned voffB[2], baseA[2][2];
#pragma unroll
    for (int i = 0; i < 2; ++i) { int R, C; stage_rc(tid * 16 + i * 8192, R, C);
        const int Rb = Epi::BJM ? (64 * (R >> 5) + 16 * ((R & 15) >> 2) + 4 * ((R >> 4) & 1) + (R & 3)) : Epi::PERM ? ((R & ~31) + perm32(R & 31)) : R;
        voffB[i] = (unsigned)(Rb * K) + 2u * (unsigned)C; baseA[0][i] = (unsigned)R * (unsigned)g.lda + 2u * (unsigned)C; baseA[1][i] = (unsigned)(R + HALF) * (unsigned)g.lda + 2u * (unsigned)C; }
    const size_t kstep = (size_t)(BK * 2);
    const size_t hstepB = Epi::BJM ? (size_t)8 * K : (size_t)HALF * K;
    const size_t tstepB = (size_t)BM * K;
    const size_t tstepA = (size_t)BM * (size_t)g.lda;
    const unsigned ldsw = (unsigned)wid * 1024u;
    const int aoff = lds_byte(wr * 64 + fr, fq * 8), boff = lds_byte(wc * 32 + fr, fq * 8);
#define PG8_SA(b, h) (((b) * 2 + (h)) * HTB)
#define PG8_SB(b, h) ((4 + (b) * 2 + (h)) * HTB)
#define PG8_STAGE(bufoff, gbase, voff) do { _Pragma("unroll") for (int _i = 0; _i < 2; ++_i) \
        __builtin_amdgcn_global_load_lds((const unsigned*)((const char*)(gbase) + (voff)[_i]), (LAS unsigned*)(lds + (bufoff) + ldsw + _i * 8192), 16, 0, 0); } while (0)
#define PG8_STAGE_A(bufoff, kb_, nx_, h_) do { if constexpr (GATHER) { _Pragma("unroll") for (int _i = 0; _i < 2; ++_i) \
            __builtin_amdgcn_global_load_lds((const unsigned*)(Ab + (kb_) + ((nx_) ? oN[h_][_i] : oC[h_][_i])), (LAS unsigned*)(lds + (bufoff) + ldsw + _i * 8192), 16, 0, 0); } \
        else { const char* _ab = Ab + (kb_) + (size_t)((nx_) ? pmN : pmC) * tstepA; _Pragma("unroll") for (int _i = 0; _i < 2; ++_i) \
            __builtin_amdgcn_global_load_lds((const unsigned*)(_ab + baseA[h_][_i]), (LAS unsigned*)(lds + (bufoff) + ldsw + _i * 8192), 16, 0, 0); } } while (0)
#define PG8_LDA(dst, b, h) do { if constexpr (FP8) { _Pragma("unroll") for (int m = 0; m < 4; ++m) dst##8[m] = __builtin_shufflevector(*(const LAS i32x4*)(lds + PG8_SA(b, h) + aoff + m * 2048), *(const LAS i32x4*)(lds + PG8_SA(b, h) + aoff + m * 2048 + 1024), 0, 1, 2, 3, 4, 5, 6, 7); } \
        else { _Pragma("unroll") for (int m = 0; m < 4; ++m) _Pragma("unroll") for (int k = 0; k < 2; ++k) dst[m][k] = *(const LAS bf16x8*)(lds + PG8_SA(b, h) + aoff + m * 2048 + k * 1024); } } while (0)
#define PG8_LDB(dst, b, h) do { if constexpr (FP8) { _Pragma("unroll") for (int n = 0; n < 2; ++n) dst##8[n] = __builtin_shufflevector(*(const LAS i32x4*)(lds + PG8_SB(b, h) + boff + n * 2048), *(const LAS i32x4*)(lds + PG8_SB(b, h) + boff + n * 2048 + 1024), 0, 1, 2, 3, 4, 5, 6, 7); } \
        else { _Pragma("unroll") for (int n = 0; n < 2; ++n) _Pragma("unroll") for (int k = 0; k < 2; ++k) dst[n][k] = *(const LAS bf16x8*)(lds + PG8_SB(b, h) + boff + n * 2048 + k * 1024); } } while (0)
#define PG8_MMA(ai, bj, At, Bt) do { __builtin_amdgcn_s_setprio(1); \
        if constexpr (FP8) { _Pragma("unroll") for (int m = 0; m < 4; ++m) _Pragma("unroll") for (int n = 0; n < 2; ++n) \
            asm volatile("v_mfma_f32_16x16x128_f8f6f4 %0, %1, %2, %0" : "+v"(acc[ai][bj][m][n]) : "v"(Bt##8[n]), "v"(At##8[m])); } \
        else { _Pragma("unroll") for (int m = 0; m < 4; ++m) _Pragma("unroll") for (int n = 0; n < 2; ++n) _Pragma("unroll") for (int k = 0; k < 2; ++k) \
            acc[ai][bj][m][n] = __builtin_amdgcn_mfma_f32_16x16x32_bf16(Bt[n][k], At[m][k], acc[ai][bj][m][n], 0, 0, 0); } \
        __builtin_amdgcn_s_setprio(0); } while (0)
#define PG8_WAIT_V(n) asm volatile("s_waitcnt vmcnt(" #n ")" ::: "memory")
#define PG8_WAIT_L(n) asm volatile("s_waitcnt lgkmcnt(" #n ")" ::: "memory")
#define PG8_BAR __builtin_amdgcn_s_barrier()
#define PG8_SCHED __builtin_amdgcn_sched_barrier(0)
#define PG8_AOFF(o, u) do { _Pragma("unroll") for (int _i = 0; _i < 2; ++_i) { int _R, _C; stage_rc(tid * 16 + _i * 8192, _R, _C); \
        _Pragma("unroll") for (int _h = 0; _h < 2; ++_h) { const int _src = g.gidx[(u).pm * BM + _h * HALF + _R]; o[_h][_i] = (unsigned)_src * (unsigned)g.lda + 2u * (unsigned)_C; } } } while (0)
    Unit cur, nxt; int ui = 0;
    if (!S.next(0, cur)) return;
    f32x4 acc[2][2][4][2];
#pragma unroll
    for (int a = 0; a < 2; ++a)
#pragma unroll
        for (int b = 0; b < 2; ++b)
#pragma unroll
            for (int m = 0; m < 4; ++m)
#pragma unroll
                for (int n = 0; n < 2; ++n) acc[a][b][m][n] = (f32x4){0.f, 0.f, 0.f, 0.f};
    bf16x8 At[4][2], B0[2][2], B1[2][2];
    i32x8 At8[4], B08[2], B18[2];
    unsigned oC[2][2], oN[2][2];
    int pmC = cur.pm, pmN = cur.pm;
    if constexpr (GATHER) { PG8_AOFF(oC, cur); }
    const char* const Ab = (const char*)g.A;
    const char* cB = (const char*)g.Bt + (size_t)cur.pb * tstepB;
    PG8_STAGE(PG8_SB(0, 0), cB, voffB); PG8_STAGE(PG8_SB(0, 1), cB + hstepB, voffB); PG8_STAGE_A(PG8_SA(0, 0), 0, false, 0); PG8_STAGE_A(PG8_SA(0, 1), 0, false, 1);
    if (wr == 1) PG8_BAR;
    PG8_WAIT_V(2); PG8_BAR;
    PG8_STAGE(PG8_SB(1, 0), cB + kstep, voffB); PG8_STAGE_A(PG8_SA(1, 0), kstep, false, 0); PG8_STAGE(PG8_SB(1, 1), cB + hstepB + kstep, voffB);
    PG8_WAIT_V(6); PG8_BAR;
    for (;;) {
        const bool has_next = S.next(ui + 1, nxt);
        const char* nB = has_next ? (const char*)g.Bt + (size_t)nxt.pb * tstepB : cB;
        pmN = has_next ? nxt.pm : pmC;
        if constexpr (Epi::BIAS_LDS) {
            if (wid >= 4) __builtin_amdgcn_global_load_lds((const unsigned*)(E.bias_ptr(cur) + (wid - 4) * 64 + lane), (LAS unsigned*)(lds + STAGE_BYTES + 8192 + 2048 + (ui & 1) * 1024 + (wid - 4) * 256), 4, 0, 0); }
        if constexpr (GATHER) {
            if (has_next && wid < 4) __builtin_amdgcn_global_load_lds((const unsigned*)(g.gidx + nxt.pm * BM + wid * 64 + lane), (LAS unsigned*)(lds + STAGE_BYTES + 8192 + ((ui + 1) & 1) * 1024 + wid * 256), 4, 0, 0);
#pragma unroll
            for (int _h = 0; _h < 2; ++_h)
#pragma unroll
                for (int _i = 0; _i < 2; ++_i) oN[_h][_i] = oC[_h][_i]; }
#pragma unroll 1
        for (int t = 0; t < nt; t += 2) {
            const bool last = (t == nt - 2);
            if constexpr (GATHER) { if (last && has_next) { const LAS int* tb = (const LAS int*)(lds + STAGE_BYTES + 8192 + ((ui + 1) & 1) * 1024);
#pragma unroll
                for (int _i = 0; _i < 2; ++_i) { int _R, _C; stage_rc(tid * 16 + _i * 8192, _R, _C);
#pragma unroll
                    for (int _h = 0; _h < 2; ++_h) oN[_h][_i] = (unsigned)tb[_h * HALF + _R] * (unsigned)g.lda + 2u * (unsigned)_C; } } }
            const size_t k1 = (size_t)(t + 1) * kstep;
            const size_t k2 = last ? 0 : (size_t)(t + 2) * kstep; const char* b2 = last ? nB : cB + (size_t)(t + 2) * kstep;
            const size_t k3 = k2 + kstep; const char* b3 = b2 + kstep;
            const bool after_epi = (t == 0) && (ui > 0);
            PG8_LDB(B0, 0, 0); PG8_LDB(B1, 0, 1); PG8_SCHED; PG8_LDA(At, 0, 0); PG8_STAGE_A(PG8_SA(1, 1), k1, false, 1);
            if (after_epi) { if constexpr (Epi::NST >= 16) { PG8_WAIT_V(24); } else { PG8_WAIT_V(16); } } else { PG8_WAIT_V(8); } PG8_WAIT_L(0); PG8_BAR; PG8_MMA(0, 0, At, B0); PG8_MMA(0, 1, At, B1); PG8_BAR; PG8_SCHED;
            PG8_LDA(At, 0, 1); PG8_STAGE(PG8_SB(0, 0), b2, voffB); PG8_STAGE(PG8_SB(0, 1), b2 + hstepB, voffB); PG8_STAGE_A(PG8_SA(0, 0), k2, last, 0);
            if (after_epi) { if constexpr (Epi::NST >= 16) { PG8_WAIT_V(24); } else { PG8_WAIT_V(16); } } else { PG8_WAIT_V(8); } PG8_WAIT_L(0); PG8_BAR; PG8_MMA(1, 0, At, B0); PG8_MMA(1, 1, At, B1); PG8_BAR; PG8_SCHED;
            PG8_LDB(B0, 1, 0); PG8_LDB(B1, 1, 1); PG8_SCHED; PG8_LDA(At, 1, 0); PG8_STAGE_A(PG8_SA(0, 1), k2, last, 1);
            PG8_WAIT_V(8); PG8_WAIT_L(0); PG8_BAR; PG8_MMA(0, 0, At, B0); PG8_MMA(0, 1, At, B1); PG8_BAR; PG8_SCHED;
            PG8_LDA(At, 1, 1); PG8_STAGE(PG8_SB(1, 0), b3, voffB); PG8_STAGE(PG8_SB(1, 1), b3 + hstepB, voffB); PG8_STAGE_A(PG8_SA(1, 0), k3, last, 0);
            PG8_WAIT_V(8); PG8_WAIT_L(0); PG8_BAR; PG8_MMA(1, 0, At, B0); PG8_MMA(1, 1, At, B1); PG8_BAR; PG8_SCHED;
        }
        if (wr == 0) PG8_BAR;
        if constexpr (FP8) asm volatile("s_nop 15\n\ts_nop 15" ::: "memory");
        E(acc, cur, wr, wc, fr, fq, (const LAS float*)(lds + STAGE_BYTES + 8192 + 2048 + (ui & 1) * 1024));
        if (!has_next) break;
#pragma unroll
        for (int a = 0; a < 2; ++a)
#pragma unroll
            for (int b = 0; b < 2; ++b)
#pragma unroll
                for (int m = 0; m < 4; ++m)
#pragma unroll
                    for (int n = 0; n < 2; ++n) acc[a][b][m][n] = (f32x4){0.f, 0.f, 0.f, 0.f};
        cur = nxt; cB = nB; pmC = pmN; ++ui;
        if constexpr (GATHER) {
#pragma unroll
            for (int _h = 0; _h < 2; ++_h)
#pragma unroll
                for (int _i = 0; _i < 2; ++_i) oC[_h][_i] = oN[_h][_i]; }
        if (wr == 1) PG8_BAR;
    }
    PG8_WAIT_V(0);
    PG8_BAR;
#undef PG8_SA
#undef PG8_SB
#undef PG8_STAGE
#undef PG8_STAGE_A
#undef PG8_LDA
#undef PG8_LDB
#undef PG8_MMA
#undef PG8_WAIT_V
#undef PG8_WAIT_L
#undef PG8_BAR
#undef PG8_SCHED
#undef PG8_AOFF
}
}
constexpr int D = 1024, NB = 16, T = 4096, TC = 256;
constexpr int ML = NB * T;
constexpr int MC = NB * TC;
constexpr int MT = ML + MC;
constexpr int SW = 2048;
constexpr int NE = 32;
constexpr int MAX_TILES = 1056;
constexpr int SLOT_ROWS = MAX_TILES * 256;
constexpr float LN_EPS = 1e-5f, GN_EPS = 64e-5f;
constexpr float DN_ALPHA = 1.189207115002721f;

constexpr size_t MiB = 1u << 20;
constexpr size_t WS_CTL = 0, CTL_ZERO_BYTES = 1 * MiB;
constexpr size_t WS_MOD = 1 * MiB;
constexpr size_t WS_WINT = 2 * MiB;
constexpr size_t WS_WOUTT = 8 * MiB;
constexpr size_t WS_GATEBT = 10 * MiB;
constexpr size_t WS_MAT1 = 11 * MiB;
constexpr size_t WS_MAT2 = 12 * MiB;
constexpr size_t WS_TOPI = 13 * MiB;
constexpr size_t WS_TOPG = 14 * MiB;
constexpr size_t WS_TOKSLOT = 15 * MiB;
constexpr size_t WS_SLOTTOK = 16 * MiB;
constexpr size_t WS_TILEE = 18 * MiB;
constexpr size_t WS_WU = 19 * MiB;
constexpr size_t WS_LNSTAT = 20 * MiB;
constexpr size_t WS_W2T = 32 * MiB;
constexpr size_t WS_Z1 = 64 * MiB;
constexpr size_t WS_X1 = 64 * MiB;
constexpr size_t WS_H = 192 * MiB;
constexpr size_t WS_MS = 192 * MiB;
constexpr size_t WS_ACT = 192 * MiB;
constexpr size_t WS_H2 = 456 * MiB;
constexpr size_t WS_Y = 456 * MiB;
constexpr size_t WS_PF = 464 * MiB;
constexpr size_t WS_MO = 520 * MiB;
constexpr size_t WS_PS = 592 * MiB;
constexpr size_t WS_MIX = 648 * MiB;
constexpr size_t WS_Z = 776 * MiB;
constexpr size_t WS_END = 1024 * MiB;
constexpr size_t OUT_W1T = 128 * MiB;
static_assert(WS_Y + (size_t)SLOT_ROWS * 1024 <= WS_END && WS_ACT + (size_t)SLOT_ROWS * 1024 <= WS_H2 && WS_MS + (size_t)MT * 4096 <= WS_PF && WS_PS + (size_t)MT * 4096 <= WS_END, "ws map");
constexpr int CW_BAR = 4096;
constexpr int CW_CNT = 8192;
constexpr int CW_CUR = 8320;
constexpr int CW_NT = 8448;

constexpr int RING_BYTES = 131072;
constexpr int LDS_BYTES = 155648;
constexpr int MISC_OFF = LDS_BYTES - 256;

struct SchedGrid {
    int nM, nN, nwg, G, c;
    __device__ void init(int nM_, int nN_, int G_, int c_) { nM = nM_; nN = nN_; nwg = nM * nN; G = G_; c = c_; }
    __device__ bool map(int L, pg8::Unit& u) const {
        int wgid = L; { const int q = nwg / 8, r = nwg % 8, xcd = wgid % 8, off = wgid / 8; wgid = (xcd < r ? xcd * (q + 1) : r * (q + 1) + (xcd - r) * q) + off; }
        const int nig = 8 * nN, gid = wgid / nig, fm = gid * 8, gsz = (nM - fm) < 8 ? (nM - fm) : 8;
        u.pm = fm + ((wgid % nig) % gsz); u.pn = (wgid % nig) / gsz; u.pb = u.pn; return true;
    }
    __device__ bool next(int i, pg8::Unit& u) const { const int L = i * G + c; if (L >= nwg) return false; return map(L, u); }
};
struct SchedInProj {
    SchedGrid g; int G, c;
    __device__ void init(int G_, int c_) { G = G_; c = c_; g.init(ML / 256, 10, G_, c_); }
    __device__ bool next(int i, pg8::Unit& u) const {
        const int L = i * G + c;
        if (L < 2560) return g.map(L, u);
        if (L >= 2560 + 128) return false;
        const int r = L - 2560; u.pm = ML / 256 + r / 8; u.pn = r % 8; u.pb = u.pn; return true;
    }
};
struct SchedMoE {
    int G, c, NT, ntiles; const LAS int* tile_e; bool rev;
    __device__ bool next(int i, pg8::Unit& u) const {
        int rt, pn;
        if (G == 256) { const int x = c & 7, j = c >> 3; const int per = 32 / NT; rt = i * (8 * per) + x * per + j / NT; pn = j % NT; }
        else { const int L = i * G + c; rt = L / NT; pn = L % NT; }
        if (rt >= ntiles) return false;
        if (rev) rt = ntiles - 1 - rt;
        u.pm = rt; u.pn = pn; u.pb = tile_e[rt] * NT + pn; return true;
    }
};

using pg8::Unit; using pg8::cvt_pk_bf16;
struct EpiInProj {
    static constexpr bool PERM = true, BJM = false; static constexpr int NST = 16; static constexpr bool BIAS_LDS = false;
    bf16_t* PS; bf16_t* PF;
    __device__ __forceinline__ void operator()(const f32x4 (&acc)[2][2][4][2], const Unit& u, int wr, int wc, int fr, int fq, const LAS float* bl) const {
        const int row0 = u.pm * 256 + wr * 64 + fr; const int col0 = u.pn * 256 + wc * 32 + 8 * fq;
        bf16_t* base; int ld;
        if (u.pn < 8) { base = PS + col0; ld = 2048; } else { base = PF + (col0 - 2048); ld = 512; }
#pragma unroll
        for (int ai = 0; ai < 2; ++ai)
#pragma unroll
            for (int m = 0; m < 4; ++m) { bf16_t* rowp = base + (size_t)(row0 + ai * 128 + m * 16) * ld;
#pragma unroll
                for (int bj = 0; bj < 2; ++bj) { const f32x4 v0 = acc[ai][bj][m][0], v1 = acc[ai][bj][m][1];
                    u32x4 w; w.x = cvt_pk_bf16(v0[0], v0[1]); w.y = cvt_pk_bf16(v0[2], v0[3]); w.z = cvt_pk_bf16(v1[0], v1[1]); w.w = cvt_pk_bf16(v1[2], v1[3]);
                    *(u32x4*)(rowp + bj * 128) = w; } }
    }
};
struct EpiBf16Plain {
    static constexpr bool PERM = true, BJM = false; static constexpr int NST = 16; static constexpr bool BIAS_LDS = false;
    bf16_t* O; int ldc;
    __device__ __forceinline__ void operator()(const f32x4 (&acc)[2][2][4][2], const Unit& u, int wr, int wc, int fr, int fq, const LAS float* bl) const {
        const int row0 = u.pm * 256 + wr * 64 + fr; const int col0 = u.pn * 256 + wc * 32 + 8 * fq;
#pragma unroll
        for (int ai = 0; ai < 2; ++ai)
#pragma unroll
            for (int m = 0; m < 4; ++m) { bf16_t* rowp = O + (size_t)(row0 + ai * 128 + m * 16) * ldc + col0;
#pragma unroll
                for (int bj = 0; bj < 2; ++bj) { const f32x4 v0 = acc[ai][bj][m][0], v1 = acc[ai][bj][m][1];
                    u32x4 w; w.x = cvt_pk_bf16(v0[0], v0[1]); w.y = cvt_pk_bf16(v0[2], v0[3]); w.z = cvt_pk_bf16(v1[0], v1[1]); w.w = cvt_pk_bf16(v1[2], v1[3]);
                    *(u32x4*)(rowp + bj * 128) = w; } }
    }
};
struct EpiGate {
    static constexpr bool PERM = true, BJM = false; static constexpr int NST = 8; static constexpr bool BIAS_LDS = false;
    const bf16_t* Z; bf16_t* MIX;
    __device__ __forceinline__ void operator()(const f32x4 (&acc)[2][2][4][2], const Unit& u, int wr, int wc, int fr, int fq, const LAS float* bl) const {
        const int row0 = u.pm * 256 + wr * 64 + fr; const int ch0 = u.pn * 128 + wc * 32 + 8 * fq;
        u32x4 z0[2][4], z1[2][4];
#pragma unroll
        for (int ai = 0; ai < 2; ++ai)
#pragma unroll
            for (int m = 0; m < 4; ++m) { const int row = row0 + ai * 128 + m * 16; z0[ai][m] = *(const u32x4*)(Z + (size_t)row * 512 + ch0); z1[ai][m] = *(const u32x4*)(Z + ((size_t)ML + row) * 512 + ch0); }
#pragma unroll
        for (int ai = 0; ai < 2; ++ai)
#pragma unroll
            for (int m = 0; m < 4; ++m) { const int row = row0 + ai * 128 + m * 16;
                const u32x4 za = z0[ai][m], zb = z1[ai][m];
                const f32x4 a0 = acc[ai][0][m][0], a1 = acc[ai][0][m][1], b0 = acc[ai][1][m][0], b1 = acc[ai][1][m][1];
                u32x4 w;
                w.x = cvt_pk_bf16(bflo(za.x) * a0[0] + bflo(zb.x) * b0[0], bfhi(za.x) * a0[1] + bfhi(zb.x) * b0[1]);
                w.y = cvt_pk_bf16(bflo(za.y) * a0[2] + bflo(zb.y) * b0[2], bfhi(za.y) * a0[3] + bfhi(zb.y) * b0[3]);
                w.z = cvt_pk_bf16(bflo(za.z) * a1[0] + bflo(zb.z) * b1[0], bfhi(za.z) * a1[1] + bfhi(zb.z) * b1[1]);
                w.w = cvt_pk_bf16(bflo(za.w) * a1[2] + bflo(zb.w) * b1[2], bfhi(za.w) * a1[3] + bfhi(zb.w) * b1[3]);
                *(u32x4*)(MIX + (size_t)row * 1024 + ch0) = w; }
    }
};
constexpr float W1_SCALE = 32.0f, W2_SCALE = 64.0f;
struct EpiSwiGLU {
    static constexpr bool PERM = true, BJM = true; static constexpr int NST = 8; static constexpr bool BIAS_LDS = true;
    unsigned char* ACT; const float* b1;
    __device__ __forceinline__ float act1(float g, float l) const {
        g = fminf(g, 7.0f); l = fminf(fmaxf(l, -7.0f), 7.0f);
        return g * sigmoidf_(1.702f * g) * (l + 1.0f);
    }
    __device__ __forceinline__ const float* bias_ptr(const Unit& u) const { return b1 + (size_t)(u.pb >> 3) * 2048 + u.pn * 256; }
    __device__ __forceinline__ void operator()(const f32x4 (&acc)[2][2][4][2], const Unit& u, int wr, int wc, int fr, int fq, const LAS float* bl) const {
        const int row0 = u.pm * 256 + wr * 64 + fr; const int col0 = u.pn * 256 + wc * 64 + 16 * fq; const int e = u.pb >> 3;
        f32x4 bv[2][2];
#pragma unroll
        for (int bj = 0; bj < 2; ++bj)
#pragma unroll
            for (int n = 0; n < 2; ++n) bv[bj][n] = *(const LAS f32x4*)(bl + wc * 64 + 16 * fq + bj * 8 + 4 * n);
#pragma unroll
        for (int ai = 0; ai < 2; ++ai)
#pragma unroll
            for (int m = 0; m < 4; ++m) { unsigned char* rowp = ACT + (size_t)(row0 + ai * 128 + m * 16) * 1024 + (col0 >> 1);
                u32x2 w2;
#pragma unroll
                for (int bj = 0; bj < 2; ++bj) { const f32x4 v0 = acc[ai][bj][m][0] * (1.0f / W1_SCALE) + bv[bj][0], v1 = acc[ai][bj][m][1] * (1.0f / W1_SCALE) + bv[bj][1];
                    unsigned w = 0u; w = __builtin_amdgcn_cvt_pk_fp8_f32(act1(v0[0], v0[1]), act1(v0[2], v0[3]), w, false); w = __builtin_amdgcn_cvt_pk_fp8_f32(act1(v1[0], v1[1]), act1(v1[2], v1[3]), w, true);
                    if (bj == 0) w2.x = w; else w2.y = w; }
                *(u32x2*)rowp = w2; }
    }
};
struct EpiY {
    static constexpr bool PERM = true, BJM = true; static constexpr int NST = 8; static constexpr bool BIAS_LDS = true;
    unsigned char* Y; const float* b2;
    __device__ __forceinline__ const float* bias_ptr(const Unit& u) const { return b2 + (size_t)(u.pb >> 2) * 1024 + u.pn * 256; }
    __device__ __forceinline__ void operator()(const f32x4 (&acc)[2][2][4][2], const Unit& u, int wr, int wc, int fr, int fq, const LAS float* bl) const {
        const int row0 = u.pm * 256 + wr * 64 + fr; const int col0 = u.pn * 256 + wc * 64 + 16 * fq; const int e = u.pb >> 2;
        f32x4 bv[2][2];
#pragma unroll
        for (int bj = 0; bj < 2; ++bj)
#pragma unroll
            for (int n = 0; n < 2; ++n) bv[bj][n] = *(const LAS f32x4*)(bl + wc * 64 + 16 * fq + bj * 8 + 4 * n);
#pragma unroll
        for (int ai = 0; ai < 2; ++ai)
#pragma unroll
            for (int m = 0; m < 4; ++m) { unsigned char* rowp = Y + (size_t)(row0 + ai * 128 + m * 16) * 1024 + col0;
                u32x4 w;
#pragma unroll
                for (int bj = 0; bj < 2; ++bj) { const f32x4 v0 = acc[ai][bj][m][0] * (1.0f / W2_SCALE) + bv[bj][0], v1 = acc[ai][bj][m][1] * (1.0f / W2_SCALE) + bv[bj][1];
                    unsigned x = 0u; x = __builtin_amdgcn_cvt_pk_fp8_f32(v0[0], v0[1], x, false); x = __builtin_amdgcn_cvt_pk_fp8_f32(v0[2], v0[3], x, true);
                    unsigned y = 0u; y = __builtin_amdgcn_cvt_pk_fp8_f32(v1[0], v1[1], y, false); y = __builtin_amdgcn_cvt_pk_fp8_f32(v1[2], v1[3], y, true);
                    if (bj == 0) { w.x = x; w.y = y; } else { w.z = x; w.w = y; } }
                *(u32x4*)rowp = w; }
    }
};
struct Args { const float* in[33]; float* out; unsigned char* ws; int ph_lo, ph_hi; };
enum { I_X = 0, I_C, I_CTX, I_CCTX, I_LN0G, I_LN0B, I_WADA, I_BADA, I_WIN, I_MU, I_W0, I_W2D, I_A0, I_A2, I_G2, I_RK, I_KK, I_KA, I_GNG, I_GNB, I_WFNO, I_BFNO, I_WOUT,
       I_LN1G, I_LN1B, I_WR, I_BR, I_W1, I_B1, I_W2, I_B2, I_LN2G, I_LN2B };

__device__ __forceinline__ void p0_transpose_item(const float* W, int ldw, int K, bf16_t* WT, int k0, int n0, LAS float* scr, int lane) {
    { float t[32];
#pragma unroll
      for (int i = 0; i < 32; ++i) { const int kk = 2 * i + (lane >> 5); t[i] = W[(size_t)(k0 + kk) * ldw + n0 + (lane & 31)]; }
#pragma unroll
      for (int i = 0; i < 32; ++i) { const int kk = 2 * i + (lane >> 5); scr[kk * 33 + (lane & 31)] = t[i]; } }
    LDS_WAIT(); asm volatile("" ::: "memory");
    const int c = lane & 7;
#pragma unroll
    for (int j = 0; j < 4; ++j) { const int n = (lane >> 3) + 8 * j; const LAS float* s = scr + (8 * c) * 33 + n;
        u32x4 o; o.x = pk2(s[0 * 33], s[1 * 33]); o.y = pk2(s[2 * 33], s[3 * 33]); o.z = pk2(s[4 * 33], s[5 * 33]); o.w = pk2(s[6 * 33], s[7 * 33]);
        *(GAS u32x4*)(WT + (size_t)(n0 + n) * K + k0 + 8 * c) = o; }
    LDS_WAIT(); asm volatile("" ::: "memory");
}

__device__ __forceinline__ void p0_transpose_item_f8(const float* W, int ldw, int K, unsigned char* WT, int k0, int n0, float scale, LAS float* scr, int lane) {
    { float t[32];
#pragma unroll
      for (int i = 0; i < 32; ++i) { const int kk = 2 * i + (lane >> 5); t[i] = W[(size_t)(k0 + kk) * ldw + n0 + (lane & 31)]; }
#pragma unroll
      for (int i = 0; i < 32; ++i) { const int kk = 2 * i + (lane >> 5); scr[kk * 33 + (lane & 31)] = t[i] * scale; } }
    LDS_WAIT(); asm volatile("" ::: "memory");
    const int c = lane & 7;
#pragma unroll
    for (int j = 0; j < 4; ++j) { const int n = (lane >> 3) + 8 * j; const LAS float* s = scr + (8 * c) * 33 + n;
        u32x2 o; unsigned w = 0u;
        w = __builtin_amdgcn_cvt_pk_fp8_f32(s[0 * 33], s[1 * 33], w, false); w = __builtin_amdgcn_cvt_pk_fp8_f32(s[2 * 33], s[3 * 33], w, true); o.x = w;
        w = 0u; w = __builtin_amdgcn_cvt_pk_fp8_f32(s[4 * 33], s[5 * 33], w, false); w = __builtin_amdgcn_cvt_pk_fp8_f32(s[6 * 33], s[7 * 33], w, true); o.y = w;
        *(GAS u32x2*)(WT + (size_t)(n0 + n) * K + k0 + 8 * c) = o; }
    LDS_WAIT(); asm volatile("" ::: "memory");
}

__device__ __forceinline__ void phase0(const Args& a, LAS unsigned char* lds, int vcu, int G, int tid, int wave, int lane) {
    unsigned char* ws = a.ws;
    for (int it = vcu; it < 192 + 8; it += G) {
        if (it < 192) {
            LAS float* s = (LAS float*)lds;
            LAS float* part = s + 1024 * 20;
            for (int idx = tid; idx < 17 * 256; idx += 512) { const int r = idx >> 8, k4 = (idx & 255) * 4; const f32x4 v = *(const f32x4*)((r < 16 ? a.in[I_C] + r * 1024 : a.in[I_CCTX]) + k4);
#pragma unroll
                for (int q = 0; q < 4; ++q) s[(k4 + q) * 20 + r] = v[q] * sigmoidf_(v[q]); }
            __syncthreads();
            const int col = lane & 31, half = lane >> 5; const int j = it * 32 + col; float acc[17];
#pragma unroll
            for (int r = 0; r < 17; ++r) acc[r] = 0.f;
            const float* wp = a.in[I_WADA] + (size_t)(128 * wave + 64 * half) * 6144 + j;
#pragma unroll 1
            for (int k0 = 0; k0 < 64; k0 += 32) { float wv[32];
#pragma unroll
                for (int u = 0; u < 32; ++u) wv[u] = wp[(size_t)(k0 + u) * 6144];
#pragma unroll
            for (int u = 0; u < 32; ++u) { const float w = wv[u]; const int k = 128 * wave + 64 * half + k0 + u;
                const f32x4 s0 = *(const LAS f32x4*)(s + k * 20), s1 = *(const LAS f32x4*)(s + k * 20 + 4), s2 = *(const LAS f32x4*)(s + k * 20 + 8), s3 = *(const LAS f32x4*)(s + k * 20 + 12); const float s4 = s[k * 20 + 16];
#pragma unroll
                for (int q = 0; q < 4; ++q) { acc[q] += s0[q] * w; acc[4 + q] += s1[q] * w; acc[8 + q] += s2[q] * w; acc[12 + q] += s3[q] * w; }
                acc[16] += s4 * w; } }
#pragma unroll
            for (int r = 0; r < 17; ++r) part[((wave * 2 + half) * 17 + r) * 32 + col] = acc[r];
            __syncthreads();
            float* MOD = (float*)(ws + WS_MOD);
            for (int idx = tid; idx < 17 * 32; idx += 512) { const int r = idx >> 5, l = idx & 31; float t = a.in[I_BADA][it * 32 + l];
#pragma unroll
                for (int w = 0; w < 16; ++w) t += part[(w * 17 + r) * 32 + l];
                MOD[r * 6144 + it * 32 + l] = t; }
            __syncthreads();
        } else {
            const int g = it - 192;
            LAS float* Wf = (LAS float*)lds;
            LAS float* AB = Wf + 4096;
            LAS float* CS = AB + 8192;
            for (int idx = tid; idx < 4096; idx += 512) Wf[idx] = a.in[I_WFNO][(size_t)g * 4096 + idx];
            if (tid < 64) { const float rev = (float)tid * (1.0f / 64.0f); CS[tid] = __builtin_amdgcn_cosf(rev); CS[64 + tid] = __builtin_amdgcn_sinf(rev); }
            __syncthreads();
            { const int c = tid >> 3, e0 = (tid & 7) * 8; float ac[8], as[8];
#pragma unroll
              for (int q = 0; q < 8; ++q) { ac[q] = 0.f; as[q] = 0.f; }
              for (int cp = 0; cp < 64; ++cp) { const int ph = (c * cp) & 63; const float cc = CS[ph], ss = CS[64 + ph];
#pragma unroll
                  for (int q = 0; q < 8; ++q) { const float w = Wf[cp * 64 + e0 + q]; ac[q] += cc * w; as[q] += ss * w; } }
#pragma unroll
              for (int q = 0; q < 8; ++q) { AB[c * 64 + e0 + q] = ac[q] * (1.0f / 512.0f); AB[4096 + c * 64 + e0 + q] = as[q] * (1.0f / 512.0f); } }
            __syncthreads();
            { bf16_t* WU = (bf16_t*)(ws + WS_WU);
              for (int idx = tid; idx < 8192; idx += 512) { const int ri = idx >> 12, e = (idx >> 6) & 63, c = idx & 63; WU[(size_t)g * 8192 + idx] = (bf16_t)f2bf(AB[ri * 4096 + c * 64 + e]); } }
            __syncthreads();
        }
    }
    {
        LAS float* scr = (LAS float*)(lds + wave * 8448);
        const int gw = vcu * 8 + wave, NGW = G * 8;
        constexpr int I_IN = 16 * 80, I_OUT = 16 * 32;
        constexpr int NIT = I_IN + I_OUT;
        for (int it = gw; it < NIT; it += NGW) {
            int r = it;
            if (r < I_IN) { p0_transpose_item(a.in[I_WIN], 2560, 1024, (bf16_t*)(ws + WS_WINT), (r / 80) * 64, (r % 80) * 32, scr, lane); continue; } r -= I_IN;
            p0_transpose_item(a.in[I_WOUT], 1024, 1024, (bf16_t*)(ws + WS_WOUTT), (r / 32) * 64, (r % 32) * 32, scr, lane);
        }
    }
    {
        const int gt = vcu * 512 + tid, NGT = G * 512;
        bf16_t* GB = (bf16_t*)(ws + WS_GATEBT);
        for (int it = gt; it < 1024 * 32; it += NGT) { const int n = it >> 5, k0 = (it & 31) * 8; const int pn = n >> 8, dir = (n >> 7) & 1, ch = pn * 128 + (n & 127);
            unsigned w[4];
#pragma unroll
            for (int q = 0; q < 4; ++q) { float v0 = 0.f, v1 = 0.f; const int ka = k0 + 2 * q, kb2 = ka + 1;
                if ((ka >> 7) == dir) { v0 = a.in[I_G2][((size_t)dir * 128 + (ka & 127)) * 512 + ch]; v1 = a.in[I_G2][((size_t)dir * 128 + (kb2 & 127)) * 512 + ch]; }
                w[q] = pk2(v0, v1); }
            *(GAS u32x4*)(GB + (size_t)n * 256 + k0) = (u32x4){w[0], w[1], w[2], w[3]}; }
        bf16_t* M1 = (bf16_t*)(ws + WS_MAT1);
        for (int it = gt; it < 128 * 16; it += NGT) { const int m = it >> 4, k0 = (it & 15) * 8; const int rip = m >> 6, t1p = m & 63; unsigned w[4];
#pragma unroll
            for (int q = 0; q < 4; ++q) { float v[2];
#pragma unroll
                for (int z = 0; z < 2; ++z) { const int k = k0 + 2 * q + z, ri = k >> 6, t1 = k & 63; const float rev = (float)((t1 * t1p) & 63) * (1.0f / 64.0f); const float cs = __builtin_amdgcn_cosf(rev), sn = __builtin_amdgcn_sinf(rev);
                    v[z] = (rip == 0) ? (ri == 0 ? cs : -sn) : (ri == 0 ? sn : cs); }
                w[q] = pk2(v[0], v[1]); }
            *(GAS u32x4*)(M1 + (size_t)m * 128 + k0) = (u32x4){w[0], w[1], w[2], w[3]}; }
        bf16_t* M2 = (bf16_t*)(ws + WS_MAT2);
        for (int it = gt; it < 64 * 64 * 16; it += NGT) { const int t1p = it >> 10, m = (it >> 4) & 63, k0 = (it & 15) * 8; unsigned w[4];
#pragma unroll
            for (int q = 0; q < 4; ++q) { float v[2];
#pragma unroll
                for (int z = 0; z < 2; ++z) { const int k = k0 + 2 * q + z, ri = k >> 6, t2 = k & 63; const float rev = (float)((t2 * (t1p + 64 * m)) & 4095) * (1.0f / 4096.0f);
                    v[z] = (ri == 0) ? __builtin_amdgcn_cosf(rev) : -__builtin_amdgcn_sinf(rev); }
                w[q] = pk2(v[0], v[1]); }
            *(GAS u32x4*)(M2 + ((size_t)t1p * 64 + m) * 128 + k0) = (u32x4){w[0], w[1], w[2], w[3]}; }
    }
}

#define P1_LOAD(dst, row) do { const float* _xr = (row) < ML ? a.in[I_X] + (size_t)(row) * D : a.in[I_CTX] + (size_t)((row) - ML) * D; \
    _Pragma("unroll") for (int j = 0; j < 4; ++j) dst[j] = __builtin_nontemporal_load((const f32x4*)(_xr + 4 * lane + 256 * j)); } while (0)
__device__ __forceinline__ void phase1(const Args& a, int vcu, int G, int wave, int lane) {
    const float* MOD = (const float*)(a.ws + WS_MOD); bf16_t* H = (bf16_t*)(a.ws + WS_H);
    const int gw = vcu * 8 + wave, NGW = G * 8;
    f32x4 g0[4], b0[4];
#pragma unroll
    for (int j = 0; j < 4; ++j) { g0[j] = *(const f32x4*)(a.in[I_LN0G] + 4 * lane + 256 * j); b0[j] = *(const f32x4*)(a.in[I_LN0B] + 4 * lane + 256 * j); }
    int pr = gw * 2;
    f32x4 va[4], vb[4];
    if (pr < MT) { P1_LOAD(va, pr); P1_LOAD(vb, pr + 1); }
    for (; pr < MT; pr += NGW * 2) {
        const int npr = pr + NGW * 2; f32x4 na[4], nb[4];
        const int mr = pr < ML ? (pr >> 12) : 16;
        f32x4 sh[4], sc[4];
#pragma unroll
        for (int j = 0; j < 4; ++j) { sh[j] = *(const f32x4*)(MOD + mr * 6144 + 4 * lane + 256 * j); sc[j] = *(const f32x4*)(MOD + mr * 6144 + 1024 + 4 * lane + 256 * j); }
        asm volatile("" ::: "memory");
        if (npr < MT) { P1_LOAD(na, npr); P1_LOAD(nb, npr + 1); }
        float sa = 0.f, sb = 0.f;
#pragma unroll
        for (int j = 0; j < 4; ++j) { sa += (va[j][0] + va[j][1]) + (va[j][2] + va[j][3]); sb += (vb[j][0] + vb[j][1]) + (vb[j][2] + vb[j][3]); }
        const float ma = wave_sum(sa) * (1.f / D), mb = wave_sum(sb) * (1.f / D); float qa = 0.f, qb = 0.f;
#pragma unroll
        for (int j = 0; j < 4; ++j) { va[j] = va[j] - ma; vb[j] = vb[j] - mb;
            qa += (va[j][0] * va[j][0] + va[j][1] * va[j][1]) + (va[j][2] * va[j][2] + va[j][3] * va[j][3]); qb += (vb[j][0] * vb[j][0] + vb[j][1] * vb[j][1]) + (vb[j][2] * vb[j][2] + vb[j][3] * vb[j][3]); }
        const float ra = frsq(wave_sum(qa) * (1.f / D) + LN_EPS), rb = frsq(wave_sum(qb) * (1.f / D) + LN_EPS);
        if (lane == 0 && pr < ML) *(GAS f32x4*)((float*)(a.ws + WS_LNSTAT) + (size_t)pr * 2) = (f32x4){ma, ra, mb, rb};
#pragma unroll
        for (int j = 0; j < 4; ++j) { const int c = 4 * lane + 256 * j;
            const f32x4 ha = (va[j] * ra * g0[j] + b0[j]) * (sc[j] + 1.0f) + sh[j], hb = (vb[j] * rb * g0[j] + b0[j]) * (sc[j] + 1.0f) + sh[j];
            u32x2 o; o.x = pk2(ha[0], ha[1]); o.y = pk2(ha[2], ha[3]); *(GAS u32x2*)(H + (size_t)pr * D + c) = o;
            o.x = pk2(hb[0], hb[1]); o.y = pk2(hb[2], hb[3]); *(GAS u32x2*)(H + (size_t)(pr + 1) * D + c) = o; }
#pragma unroll
        for (int j = 0; j < 4; ++j) { va[j] = na[j]; vb[j] = nb[j]; }
    }
}
#undef P1_LOAD

__device__ __forceinline__ void unpack8(const u32x4 w, float (&f)[8]) { f[0] = bflo(w.x); f[1] = bfhi(w.x); f[2] = bflo(w.y); f[3] = bfhi(w.y); f[4] = bflo(w.z); f[5] = bfhi(w.z); f[6] = bflo(w.w); f[7] = bfhi(w.w); }
__device__ __forceinline__ void acc8(const u32x4 w, float (&f)[8]) { f[0] += bflo(w.x); f[1] += bfhi(w.x); f[2] += bflo(w.y); f[3] += bfhi(w.y); f[4] += bflo(w.z); f[5] += bfhi(w.z); f[6] += bflo(w.w); f[7] += bfhi(w.w); }
__device__ __forceinline__ void shift_out8(const u32x4 c, const u32x4 l, const u32x4 r, const u32x4 u, const u32x4 d, const float (&mu)[8], float scale, int actk, float ns, float al, float be, bf16_t* dst) {
    float sv[8], nb[8];
    unpack8(c, sv);
#pragma unroll
    for (int z = 0; z < 8; ++z) nb[z] = 0.f;
    acc8(l, nb); acc8(r, nb); acc8(u, nb); acc8(d, nb);
    float m[8];
#pragma unroll
    for (int z = 0; z < 8; ++z) m[z] = sv[z] + mu[z] * (nb[z] * scale - sv[z]);
    if (actk != 0) {
#pragma unroll
        for (int z = 0; z < 8; ++z) m[z] = al * frcp(1.0f + __expf(ns * m[z])) + be; }
    u32x4 o; o.x = pk2(m[0], m[1]); o.y = pk2(m[2], m[3]); o.z = pk2(m[4], m[5]); o.w = pk2(m[6], m[7]);
    *(GAS u32x4*)dst = o;
}
__device__ __forceinline__ void phase3_shift(const Args& a, int vcu, int G, int tid) {
    const bf16_t* PS = (const bf16_t*)(a.ws + WS_PS); bf16_t* MS = (bf16_t*)(a.ws + WS_MS);
    const int cb = (tid & 255) * 8; float mu[8];
#pragma unroll
    for (int q = 0; q < 8; ++q) mu[q] = a.in[I_MU][cb + q];
    const int actk = (cb >= 1536 && cb < 1664) ? 1 : (cb >= 1792 ? 2 : 0);
    const float ns = actk == 1 ? -2.0f : -1.0f, al = actk == 1 ? 2.0f : 1.0f, be = actk == 1 ? -1.0f : 0.0f;
    const u32x4 zz = {0u, 0u, 0u, 0u};
    for (int it = vcu * 2 + (tid >> 8); it < 512; it += 2 * G) {
        const int b = it >> 5, r8 = (it >> 2) & 7, seg = it & 3; const int gx0 = 8 * r8, g0 = 16 * seg;
        const bool hasL = gx0 > 0, hasR = gx0 < 56;
        const bf16_t* base = PS + ((size_t)b * 4096 + gx0) * SW + cb;
        u32x4 P[8], C[10], N[10], N2[10];
#define SH_LOADROW(dst, g) do { const bf16_t* _rp = base + (size_t)(g) * 64 * SW; dst[0] = hasL ? *(const u32x4*)(_rp - SW) : zz; dst[9] = hasR ? *(const u32x4*)(_rp + 8 * SW) : zz; \
        _Pragma("unroll") for (int q = 0; q < 8; ++q) dst[1 + q] = *(const u32x4*)(_rp + (size_t)q * SW); } while (0)
        if (g0 > 0) {
#pragma unroll
            for (int q = 0; q < 8; ++q) P[q] = *(const u32x4*)(base + (size_t)(g0 - 1) * 64 * SW + (size_t)q * SW); }
        else {
#pragma unroll
            for (int q = 0; q < 8; ++q) P[q] = zz; }
        SH_LOADROW(C, g0);
        SH_LOADROW(N, g0 + 1);
#pragma unroll 1
        for (int g = g0; g < g0 + 16; ++g) {
            if (g + 2 <= 63 && g + 2 <= g0 + 16) { SH_LOADROW(N2, g + 2); } else {
#pragma unroll
                for (int q = 0; q < 10; ++q) N2[q] = zz; }
#pragma unroll
            for (int q = 0; q < 8; ++q) shift_out8(C[1 + q], C[q], C[2 + q], P[q], N[1 + q], mu, 0.25f, actk, ns, al, be, MS + ((size_t)b * 4096 + g * 64 + gx0 + q) * SW + cb);
#pragma unroll
            for (int q = 0; q < 8; ++q) P[q] = C[1 + q];
#pragma unroll
            for (int q = 0; q < 10; ++q) { C[q] = N[q]; N[q] = N2[q]; }
        }
#undef SH_LOADROW
    }
    for (int rn = vcu * 2 + (tid >> 8); rn < MC / 8; rn += 2 * G) {
        const int r0 = ML + rn * 8; const int t0 = (rn * 8) & 255; const bool hasL = t0 > 0, hasR = t0 < 248;
        const bf16_t* base = PS + (size_t)r0 * SW + cb; u32x4 C[10];
        C[0] = hasL ? *(const u32x4*)(base - SW) : zz; C[9] = hasR ? *(const u32x4*)(base + 8 * SW) : zz;
#pragma unroll
        for (int q = 0; q < 8; ++q) C[1 + q] = *(const u32x4*)(base + (size_t)q * SW);
#pragma unroll
        for (int q = 0; q < 8; ++q) shift_out8(C[1 + q], C[q], C[2 + q], zz, zz, mu, 0.5f, actk, ns, al, be, MS + (size_t)(r0 + q) * SW + cb);
    }
}

constexpr int MOE_W_ITEMS = 32768 + 16384;
__device__ __forceinline__ void moe_weight_addr(const Args& a, int item, int lane, const float*& src, unsigned char*& dst, int& ldw, float& scale) {
    const float* W; unsigned char* WT; int k0, n0;
    if (item < 32768) { const int e = item >> 10, r = item & 1023; W = a.in[I_W1] + (size_t)e * 1024 * 2048; ldw = 2048; k0 = (r >> 5) * 32; n0 = (r & 31) * 64; WT = (unsigned char*)a.out + OUT_W1T + (size_t)e * 2048 * 1024; scale = W1_SCALE; }
    else { const int q = item - 32768, e = q >> 9, r = q & 511; W = a.in[I_W2] + (size_t)e * 1024 * 1024; ldw = 1024; k0 = (r >> 4) * 32; n0 = (r & 15) * 64; WT = a.ws + WS_W2T + (size_t)e * 1024 * 1024; scale = W2_SCALE; }
    src = W + (size_t)k0 * ldw + n0 + lane; dst = WT + (size_t)(n0 + lane) * 1024 + k0;
}
__device__ __forceinline__ void moe_weight_dma(const Args& a, int item, int lane, LAS unsigned char* wb) {
    const float* src; unsigned char* dst; int ldw; float scale; moe_weight_addr(a, item, 0, src, dst, ldw, scale);
#pragma unroll
    for (int q = 0; q < 8; ++q) __builtin_amdgcn_global_load_lds((const unsigned*)(src + (size_t)(4 * q + (lane >> 4)) * ldw + (lane & 15) * 4), (LAS unsigned*)(wb + q * 1024), 16, 0, 2);
}
__device__ __forceinline__ void moe_weight_cvt(const Args& a, int item, int lane, const LAS unsigned char* wb) {
    const float* src; unsigned char* dst; int ldw; float scale; moe_weight_addr(a, item, lane, src, dst, ldw, scale);
    float t[32];
#pragma unroll
    for (int i = 0; i < 32; ++i) t[i] = ((const LAS float*)wb)[i * 64 + lane];
    unsigned w[8];
#pragma unroll
    for (int q = 0; q < 8; ++q) { unsigned x = 0u; x = __builtin_amdgcn_cvt_pk_fp8_f32(t[4 * q] * scale, t[4 * q + 1] * scale, x, false); x = __builtin_amdgcn_cvt_pk_fp8_f32(t[4 * q + 2] * scale, t[4 * q + 3] * scale, x, true); w[q] = x; }
    *(GAS u32x4*)dst = (u32x4){w[0], w[1], w[2], w[3]}; *(GAS u32x4*)(dst + 16) = (u32x4){w[4], w[5], w[6], w[7]};
}
typedef short s16x4 __attribute__((ext_vector_type(4)));
__device__ __forceinline__ s16x4 lds_tr16(const LAS void* p) { return __builtin_amdgcn_ds_read_tr16_b64_v4i16((LAS s16x4*)p); }
#define SWZV(n_, j_) ((n_) * 64 + (((((j_) >> 3) ^ ((((n_) >> 2) & 3) << 1)) << 3) | ((j_) & 7)))
#define SWZ64(n_, j_) ((n_) * 64 + (((((j_) >> 3) ^ ((n_) & 7)) << 3) | ((j_) & 7)))
#define MFMA32(a_, b_, c_) __builtin_amdgcn_mfma_f32_16x16x32_bf16(a_, b_, c_, 0, 0, 0)
__device__ __forceinline__ bf16x8 pk8(const s16x4 lo, const s16x4 hi) { return __builtin_shufflevector(lo, hi, 0, 1, 2, 3, 4, 5, 6, 7); }
#define MFMA16(a_, b_, c_) MFMA32(pk8(a_, (s16x4){0, 0, 0, 0}), pk8(b_, (s16x4){0, 0, 0, 0}), c_)
typedef __bf16 bf16x4_t __attribute__((ext_vector_type(4)));
__device__ __forceinline__ s16x4 cvt4(const f32x4 v) { const bf16x4_t b = __builtin_convertvector(v, bf16x4_t); return __builtin_bit_cast(s16x4, b); }
__device__ __forceinline__ void phase4_scan(const Args& a, LAS unsigned char* lds, int vcu, int G, int tid, int wave, int lane) {
    const bf16_t* MS = (const bf16_t*)(a.ws + WS_MS); bf16_t* Z = (bf16_t*)(a.ws + WS_Z);
    constexpr int FS = 68;
    LAS float* R = (LAS float*)lds; LAS float* KD = (LAS float*)(lds + 17408); LAS float* E = (LAS float*)(lds + 51200); LAS float* BB = (LAS float*)(lds + 68608); LAS unsigned short* Yb = (LAS unsigned short*)(lds + 98304);
    LAS unsigned char* ATb = lds + 34816; LAS unsigned char* RTb = lds + 43008;
    LAS unsigned char* BTb = lds + 122880; LAS unsigned char* KTb = lds + 131072;
    LAS unsigned char* TWb = lds + 122880; LAS unsigned char* ADb = lds + 132096;
    LAS float* BONUS = (LAS float*)(lds + 141312); LAS float* CV = BONUS + 64;
    LAS unsigned short* const VT0 = (LAS unsigned short*)(lds + 143360); LAS unsigned short* const VT1 = (LAS unsigned short*)(lds + 86016);
    LAS float* WL = (LAS float*)(lds + 151552);
    LAS float* INV = (LAS float*)(lds + 152576);
    LAS unsigned char* FRG = lds;
    LAS unsigned char* BFL = lds + 106496;
    const int fr = lane & 15, fq = lane >> 4;
    for (int chain = vcu; chain < 256; chain += G) {
        const int d = chain >> 7, b = (chain >> 3) & 15, h = chain & 7;
        __syncthreads();
        if (tid < 64) { CV[tid] = a.in[I_W0][d * 512 + h * 64 + tid]; CV[64 + tid] = a.in[I_A0][d * 512 + h * 64 + tid]; CV[128 + tid] = a.in[I_KK][h * 64 + tid]; CV[192 + tid] = a.in[I_KA][h * 64 + tid];
            CV[256 + tid] = a.in[I_RK][(d * 8 + h) * 64 + tid]; CV[320 + tid] = a.in[I_GNG][h * 64 + tid]; CV[384 + tid] = a.in[I_GNB][h * 64 + tid]; }
        const int sel = wave >> 2, mt = wave & 3;
        {
            const float* w2d = a.in[I_W2D] + (size_t)d * 64 * 512 + h * 64; const float* a2p = a.in[I_A2] + (size_t)d * 64 * 512 + h * 64;
#pragma unroll 2
            for (int idx = tid; idx < 4096; idx += 512) { const int c = idx >> 6, j = idx & 63; R[idx] = w2d[(size_t)c * 512 + j]; KD[idx] = a2p[(size_t)c * 512 + j]; }
            __syncthreads();
            if (mt == 0) { const LAS float* Wl = sel ? KD : R;
#pragma unroll
                for (int nt = 0; nt < 4; ++nt)
#pragma unroll
                    for (int ks = 0; ks < 2; ++ks) { bf16x8 f;
#pragma unroll
                        for (int jj = 0; jj < 8; ++jj) f[jj] = (short)f2bf(Wl[(32 * ks + 8 * fq + jj) * 64 + 16 * nt + fr]);
                        *(LAS bf16x8*)(BFL + ((sel * 8 + nt * 2 + ks) * 64 + lane) * 16) = f; } }
            __syncthreads();
        }
        f32x4 ST[4];
#pragma unroll
        for (int jt = 0; jt < 4; ++jt) ST[jt] = (f32x4){0.f, 0.f, 0.f, 0.f};
        const int tt = tid >> 3, seg = tid & 7, pn = d ? 63 - tt : tt;
        u32x4 pR, pK, pV, pW, pA;
#define SCAN_BAR() do { LDS_WAIT(); __builtin_amdgcn_s_barrier(); asm volatile("" ::: "memory"); } while (0)
#define SCAN_ROW0(cc) ((cc) < 4 ? (ML + b * 256 + 64 * (d ? 3 - (cc) : (cc))) : (b * 4096 + 64 * (d ? 63 - ((cc) - 4) : ((cc) - 4))))
#define SCAN_LOAD(cc) do { const bf16_t* mrow = MS + (size_t)(SCAN_ROW0(cc) + tt) * SW; \
        pR = *(const u32x4*)(mrow + h * 64 + 8 * seg); pK = *(const u32x4*)(mrow + 512 + h * 64 + 8 * seg); pV = *(const u32x4*)(mrow + 1024 + h * 64 + 8 * seg); \
        pW = *(const u32x4*)(mrow + 1536 + d * 64 + 8 * seg); pA = *(const u32x4*)(mrow + 1664 + d * 64 + 8 * seg); } while (0)
        SCAN_LOAD(0);
        for (int cc = 0; cc < 68; ++cc) {
            const int row0 = SCAN_ROW0(cc); const bool is_lat = cc >= 4;
            LAS unsigned short* const VT = (cc & 1) ? VT1 : VT0;
            if (wave >= 4 && chain == vcu && cc > 0) { const int item = ((cc - 1) * 4 + (wave - 4)) * G + vcu;
                if (item < MOE_W_ITEMS) { asm volatile("s_waitcnt vmcnt(0)" ::: "memory"); moe_weight_cvt(a, item, lane, lds + 51200 + (wave - 4) * 8192); } }
            { float f[8];
              unpack8(pR, f); *(LAS f32x4*)(R + pn * FS + 8 * seg) = (f32x4){f[0], f[1], f[2], f[3]}; *(LAS f32x4*)(R + pn * FS + 8 * seg + 4) = (f32x4){f[4], f[5], f[6], f[7]};
              unpack8(pK, f); *(LAS f32x4*)(KD + pn * FS + 8 * seg) = (f32x4){f[0], f[1], f[2], f[3]}; *(LAS f32x4*)(KD + pn * FS + 8 * seg + 4) = (f32x4){f[4], f[5], f[6], f[7]};
              { float ss = 0.f;
#pragma unroll
                for (int q = 0; q < 8; ++q) { const float kkr = f[q] * CV[128 + 8 * seg + q]; ss += kkr * kkr; }
                ss = red8(ss); if (seg == 0) INV[pn] = frcp(fmaxf(__builtin_amdgcn_sqrtf(ss), 1e-12f)); }
              *(LAS u32x4*)(VT + SWZV(pn, 8 * seg)) = pV;
              *(LAS u32x4*)(TWb + pn * 144 + seg * 16) = pW; *(LAS u32x4*)(ADb + pn * 144 + seg * 16) = pA; }
            SCAN_BAR();
            { const LAS unsigned char* Ab = sel ? ADb : TWb;
              const bf16x8 A0 = *(const LAS bf16x8*)(Ab + (16 * mt + fr) * 144 + 16 * fq), A1 = *(const LAS bf16x8*)(Ab + (16 * mt + fr) * 144 + 64 + 16 * fq);
              LAS float* const dstA = sel ? BB : E; const float mulA = sel ? 1.0f : -0.6065306597126334f; const int cvo = sel ? 64 : 0;
              bf16x8 bq[8]; float cvv[4];
#pragma unroll
              for (int k8 = 0; k8 < 8; ++k8) bq[k8] = *(const LAS bf16x8*)(BFL + ((sel * 8 + k8) * 64 + lane) * 16);
#pragma unroll
              for (int nt = 0; nt < 4; ++nt) cvv[nt] = CV[cvo + 16 * nt + fr];
              __builtin_amdgcn_sched_barrier(0);
              f32x4 acc[4];
#pragma unroll
              for (int nt = 0; nt < 4; ++nt) { acc[nt] = (f32x4){0.f, 0.f, 0.f, 0.f};
                  acc[nt] = __builtin_amdgcn_mfma_f32_16x16x32_bf16(A0, bq[2 * nt], acc[nt], 0, 0, 0); acc[nt] = __builtin_amdgcn_mfma_f32_16x16x32_bf16(A1, bq[2 * nt + 1], acc[nt], 0, 0, 0); }
#pragma unroll
              for (int nt = 0; nt < 4; ++nt)
#pragma unroll
                  for (int rg = 0; rg < 4; ++rg) { const int tok = 16 * mt + 4 * fq + rg, j = 16 * nt + fr;
                      dstA[tok * FS + j] = mulA * sigmoidf_(cvv[nt] + acc[nt][rg]); } }
            SCAN_BAR();
            { const int sc = tid >> 7, tq = (tid >> 5) & 3, jp = tid & 31; f32x2 lw = {0.f, 0.f};
              const f32x2 kkc = *(const LAS f32x2*)(CV + 128 + 2 * jp), kac = *(const LAS f32x2*)(CV + 192 + 2 * jp), rkc = *(const LAS f32x2*)(CV + 256 + 2 * jp);
              f32x2 pe[12], e4[4], av4[4], rr4[4], kr4[4]; float inv4[4];
#pragma unroll
              for (int t = 0; t < 12; ++t) pe[t] = *(const LAS f32x2*)(E + (16 * sc + t) * FS + 2 * jp);
#pragma unroll
              for (int q = 0; q < 4; ++q) { const int n = 16 * sc + 4 * tq + q, of = n * FS + 2 * jp;
                  e4[q] = *(const LAS f32x2*)(E + of); av4[q] = *(const LAS f32x2*)(BB + of); rr4[q] = *(const LAS f32x2*)(R + of); kr4[q] = *(const LAS f32x2*)(KD + of); inv4[q] = INV[n]; }
              __builtin_amdgcn_sched_barrier(0);
#pragma unroll
              for (int t = 0; t < 12; ++t) { if (t < 4 * tq) lw += pe[t]; }
              f32x2 Wc = {__expf(lw[0]), __expf(lw[1])};
#pragma unroll
              for (int q = 0; q < 4; ++q) { const int n = 16 * sc + 4 * tq + q, o = SWZ64(n, 2 * jp);
                  const f32x2 e = e4[q], av = av4[q], rr = rr4[q], kr = kr4[q]; const float inv = inv4[q];
                  const f32x2 kk = kr * kkc * inv, aa = -kk, bb = kk * av, kd = kr * ((av - 1.0f) * kac + 1.0f);
                  float bon = rr[0] * kd[0] * rkc[0] + rr[1] * kd[1] * rkc[1];
                  bon = red16(bon); bon += dpp_mov_rm<0x142, 0xA>(bon);
                  if (jp == 31) BONUS[n] = bon;
                  const f32x2 Wp = Wc; lw += e; Wc = (f32x2){__expf(lw[0]), __expf(lw[1])}; const f32x2 Wi = {__builtin_amdgcn_rcpf(Wc[0]), __builtin_amdgcn_rcpf(Wc[1])};
                  typedef __bf16 bf16x2_t __attribute__((ext_vector_type(2)));
                  *(LAS unsigned*)(ATb + o * 2) = __builtin_bit_cast(unsigned, __builtin_convertvector(aa * Wp, bf16x2_t)); *(LAS unsigned*)(BTb + o * 2) = __builtin_bit_cast(unsigned, __builtin_convertvector(bb * Wi, bf16x2_t));
                  *(LAS unsigned*)(RTb + o * 2) = __builtin_bit_cast(unsigned, __builtin_convertvector(rr * Wc, bf16x2_t)); *(LAS unsigned*)(KTb + o * 2) = __builtin_bit_cast(unsigned, __builtin_convertvector(kd * Wi, bf16x2_t)); }
              if (tq == 3) *(LAS f32x2*)(WL + sc * 64 + 2 * jp) = Wc; }
            SCAN_BAR();
            if (wave < 4) { const int sc = wave; const f32x4 Zf = {0.f, 0.f, 0.f, 0.f};
#define ROWFRAG8(base_, k2_) (*(const LAS bf16x8*)((base_) + SWZ64(16 * sc + fr, 32 * (k2_) + 8 * fq) * 2))
                bf16x8 fA[2], fB[2], fK[2], fR[2]; unsigned short ub[4][4], uk[4][4];
#pragma unroll
                for (int k2 = 0; k2 < 2; ++k2) { fA[k2] = ROWFRAG8(ATb, k2); fB[k2] = ROWFRAG8(BTb, k2); fK[k2] = ROWFRAG8(KTb, k2); fR[k2] = ROWFRAG8(RTb, k2); }
#pragma unroll
                for (int jt = 0; jt < 4; ++jt)
#pragma unroll
                    for (int q = 0; q < 4; ++q) { const int off = SWZ64(16 * sc + 4 * fq + q, 16 * jt + fr); ub[jt][q] = ((const LAS unsigned short*)BTb)[off]; uk[jt][q] = ((const LAS unsigned short*)KTb)[off]; }
                __builtin_amdgcn_sched_barrier(0);
                f32x4 Mab = Zf, MabT = Zf;
#pragma unroll
                for (int k2 = 0; k2 < 2; ++k2) { Mab = MFMA32(fB[k2], fA[k2], Mab); MabT = MFMA32(fA[k2], fB[k2], MabT); }
                f32x4 Tm, TT;
#pragma unroll
                for (int rg = 0; rg < 4; ++rg) { const int rr = 4 * fq + rg;
                    Mab[rg] = rr < fr ? Mab[rg] : 0.f; MabT[rg] = fr < rr ? MabT[rg] : 0.f;
                    const float id = rr == fr ? 1.f : 0.f; Tm[rg] = id + Mab[rg]; TT[rg] = id + MabT[rg]; }
                {   f32x4 Mp = Mab, MpT = MabT;
#pragma unroll
                    for (int itn = 0; itn < 3; ++itn) { const s16x4 cMp = cvt4(Mp), cMpT = cvt4(MpT);
                        const f32x4 Mn = MFMA16(cMpT, cMp, Zf), MnT = MFMA16(cMp, cMpT, Zf);
                        const s16x4 cMn = cvt4(Mn), cTTi = cvt4(TT);
                        const f32x4 Tn = MFMA16(cTTi, cMn, Tm), TnT = MFMA16(cMn, cTTi, TT);
                        Tm = Tn; TT = TnT; Mp = Mn; MpT = MnT; } }
                const s16x4 cT = cvt4(Tm), cTT = cvt4(TT);
                f32x4 MakT = Zf;
#pragma unroll
                for (int k2 = 0; k2 < 2; ++k2) MakT = MFMA32(fA[k2], fK[k2], MakT);
#pragma unroll
                for (int rg = 0; rg < 4; ++rg) { const int rr = 4 * fq + rg; MakT[rg] = fr < rr ? MakT[rg] : 0.f; }
                const f32x4 PT = MFMA16(cT, cvt4(MakT), Zf);
                const s16x4 cPT = cvt4(PT);
                f32x4 Mrb = Zf, Mrk = Zf;
#pragma unroll
                for (int k2 = 0; k2 < 2; ++k2) { Mrb = MFMA32(fB[k2], fR[k2], Mrb); Mrk = MFMA32(fK[k2], fR[k2], Mrk); }
#pragma unroll
                for (int rg = 0; rg < 4; ++rg) { const int rr = 4 * fq + rg; Mrb[rg] = rr <= fr ? Mrb[rg] : 0.f; Mrk[rg] = rr <= fr ? Mrk[rg] : 0.f; }
                const s16x4 cMrb = cvt4(Mrb);
                const f32x4 Nn = MFMA16(cPT, cMrb, Mrk), N2 = MFMA16(cTT, cMrb, Zf);
                LAS unsigned char* fo = FRG + (sc * 5) * 1024 + lane * 16;
                *(LAS bf16x8*)(fo) = pk8(cvt4(N2), cvt4(Nn));
#pragma unroll
                for (int jt = 0; jt < 4; ++jt) { s16x4 bfr; f32x4 kc;
#pragma unroll
                    for (int q = 0; q < 4; ++q) { bfr[q] = (short)ub[jt][q]; kc[q] = bflo((unsigned)uk[jt][q]); }
                    const f32x4 B2 = MFMA16(cTT, bfr, Zf), K2 = MFMA16(cPT, bfr, kc);
                    *(LAS bf16x8*)(fo + (1 + jt) * 1024) = pk8(cvt4(B2), cvt4(K2)); }
#undef ROWFRAG8
            } else if (chain == vcu) { const int item = (cc * 4 + (wave - 4)) * G + vcu; if (item < MOE_W_ITEMS) moe_weight_dma(a, item, lane, lds + 51200 + (wave - 4) * 8192); }
            LDS_WAIT(); __builtin_amdgcn_s_barrier(); asm volatile("" ::: "memory");
            if (cc + 1 < 68) SCAN_LOAD(cc + 1);
            if (wave < 4) { const int it = wave; const f32x4 Zf = {0.f, 0.f, 0.f, 0.f};
                struct COpsA { s16x4 a[4], r[4]; unsigned short v[4]; }; struct COpsB { bf16x8 f[5]; f32x4 w[4]; };
#define C_LOAD_A(O, sc_) do { \
    _Pragma("unroll") for (int c4 = 0; c4 < 4; ++c4) { O.a[c4] = *(const LAS s16x4*)(ATb + SWZ64(16 * (sc_) + fr, 16 * c4 + 4 * fq) * 2); O.r[c4] = *(const LAS s16x4*)(RTb + SWZ64(16 * (sc_) + fr, 16 * c4 + 4 * fq) * 2); } \
    _Pragma("unroll") for (int q = 0; q < 4; ++q) O.v[q] = VT[SWZV(16 * (sc_) + 4 * fq + q, 16 * it + fr)]; } while (0)
#define C_LOAD_B(O, sc_) do { \
    _Pragma("unroll") for (int k5 = 0; k5 < 5; ++k5) O.f[k5] = *(const LAS bf16x8*)(FRG + ((sc_) * 5 + k5) * 1024 + lane * 16); \
    _Pragma("unroll") for (int jt = 0; jt < 4; ++jt) O.w[jt] = *(const LAS f32x4*)(WL + (sc_) * 64 + 16 * jt + 4 * fq); } while (0)
                COpsA ca, na; C_LOAD_A(ca, 0);
#pragma unroll
                for (int sc = 0; sc < 4; ++sc) {
                    COpsB cb; C_LOAD_B(cb, sc);
                    __builtin_amdgcn_sched_barrier(0);
                    const bf16x8 bS01 = pk8(cvt4(ST[0]), cvt4(ST[1])), bS23 = pk8(cvt4(ST[2]), cvt4(ST[3]));
                    f32x4 XT = MFMA32(pk8(ca.a[0], ca.a[1]), bS01, Zf); XT = MFMA32(pk8(ca.a[2], ca.a[3]), bS23, XT);
                    f32x4 YT = MFMA32(pk8(ca.r[0], ca.r[1]), bS01, Zf); YT = MFMA32(pk8(ca.r[2], ca.r[3]), bS23, YT);
                    s16x4 Vf;
#pragma unroll
                    for (int q = 0; q < 4; ++q) Vf[q] = (short)ca.v[q];
                    __builtin_amdgcn_sched_barrier(0);
                    if (sc < 3) C_LOAD_A(na, sc + 1);
                    __builtin_amdgcn_sched_barrier(0);
                    const bf16x8 BX = pk8(cvt4(XT), Vf);
                    YT = MFMA32(cb.f[0], BX, YT);
#pragma unroll
                    for (int jt = 0; jt < 4; ++jt) { const f32x4 acc = MFMA32(cb.f[1 + jt], BX, ST[jt]); ST[jt] = acc * cb.w[jt]; }
                    { const unsigned y01 = pk2(YT[0], YT[1]), y23 = pk2(YT[2], YT[3]); LAS unsigned short* yp = Yb + SWZV(16 * sc + 4 * fq, 16 * it + fr);
                      yp[0] = (unsigned short)y01; yp[64] = (unsigned short)(y01 >> 16); yp[128] = (unsigned short)y23; yp[192] = (unsigned short)(y23 >> 16); }
                    __builtin_amdgcn_sched_barrier(0);
                    ca = na;
                }
#undef C_LOAD_A
#undef C_LOAD_B
            }

            SCAN_BAR();
            if (is_lat) { const int pp = tid >> 3, iq = seg; const u32x4 yw = *(const LAS u32x4*)(Yb + SWZV(pp, 8 * iq));
                const u32x4 vw = *(const LAS u32x4*)(VT + SWZV(pp, 8 * iq)); const float bon = BONUS[pp];
                const f32x4 gg0 = *(const LAS f32x4*)(CV + 320 + 8 * iq), gg1 = *(const LAS f32x4*)(CV + 324 + 8 * iq), gb0 = *(const LAS f32x4*)(CV + 384 + 8 * iq), gb1 = *(const LAS f32x4*)(CV + 388 + 8 * iq);
                __builtin_amdgcn_sched_barrier(0);
                float y[8]; unpack8(yw, y); float s = 0.f;
#pragma unroll
                for (int q = 0; q < 8; ++q) s += y[q];
                const float mean = red8(s) * (1.0f / 64.0f); float qq = 0.f;
#pragma unroll
                for (int q = 0; q < 8; ++q) { y[q] -= mean; qq += y[q] * y[q]; }
                const float rstd = frsq(red8(qq) * (1.0f / 64.0f) + GN_EPS); float o[8];
                float vv[8]; unpack8(vw, vv);
#pragma unroll
                for (int q = 0; q < 8; ++q) { const float gq = q < 4 ? gg0[q & 3] : gg1[q & 3], bq_ = q < 4 ? gb0[q & 3] : gb1[q & 3]; o[q] = y[q] * rstd * gq + bq_ + bon * vv[q]; }
                u32x4 w; w.x = pk2(o[0], o[1]); w.y = pk2(o[2], o[3]); w.z = pk2(o[4], o[5]); w.w = pk2(o[6], o[7]);
                *(GAS u32x4*)(Z + ((size_t)d * ML + row0 + (d ? 63 - pp : pp)) * 512 + h * 64 + 8 * iq) = w; }
        }
        __syncthreads();
#undef SCAN_ROW0
#undef SCAN_BAR
#undef SCAN_LOAD
    }
}

#define DFT_BAR() do { LDS_WAIT(); __builtin_amdgcn_s_barrier(); asm volatile("" ::: "memory"); } while (0)
template <int MTL, bool EXPAND>
__device__ __forceinline__ void dft_item(LAS unsigned char* lds, const bf16_t* src0, size_t src_stride, const bf16_t* Mat, bf16_t* dst0, size_t dst_stride, const float* bias, const bf16_t* WU, int wave, int lane,
                                         u32x4 (&pf)[8], bool pf_valid, const bf16_t* nsrc0) {
    constexpr int RS = 1040;
    constexpr int UTS = 272;
    const int fr = lane & 15, fq = lane >> 4;
    const int n0 = wave * 64;
    float bvs[4];
#pragma unroll
    for (int nt = 0; nt < 4; ++nt) bvs[nt] = bias ? bias[n0 + 16 * nt + fr] : 0.f;
    if constexpr (EXPAND) {
        { if (!pf_valid) {
#pragma unroll
              for (int rr = 0; rr < 8; ++rr) { const int k = wave * 8 + rr; pf[rr] = *(const u32x4*)(src0 + (size_t)k * src_stride + lane * 8); } }
#pragma unroll
          for (int rr = 0; rr < 8; ++rr) { const int k = wave * 8 + rr; LAS unsigned char* p = lds + k * RS + lane * 16; *(LAS u32x2*)p = (u32x2){pf[rr].x, pf[rr].y}; *(LAS u32x2*)(p + 8) = (u32x2){pf[rr].z, pf[rr].w}; }
          if (nsrc0) {
#pragma unroll
              for (int rr = 0; rr < 8; ++rr) { const int k = wave * 8 + rr; pf[rr] = *(const u32x4*)(nsrc0 + (size_t)k * src_stride + lane * 8); } } }
        DFT_BAR();
        bf16x8 Af[4][2];
#pragma unroll
        for (int m = 0; m < 4; ++m)
#pragma unroll
            for (int ks = 0; ks < 2; ++ks) Af[m][ks] = *(const LAS bf16x8*)(lds + (16 * m + fr) * RS + (n0 + 32 * ks + 8 * fq) * 2);
        DFT_BAR();
#pragma unroll 1
        for (int ri = 0; ri < 2; ++ri) {
            f32x4 acc[4][4]; bf16x8 Bfx[2][4];
#pragma unroll
            for (int m = 0; m < 4; ++m)
#pragma unroll
                for (int n = 0; n < 4; ++n) acc[m][n] = (f32x4){0.f, 0.f, 0.f, 0.f};
#pragma unroll
            for (int ks = 0; ks < 2; ++ks)
#pragma unroll
                for (int nt = 0; nt < 4; ++nt) Bfx[ks][nt] = *(const bf16x8*)(WU + ((size_t)((wave * 2 + ri) * 64 + 16 * nt + fr)) * 64 + 32 * ks + 8 * fq);
#pragma unroll
            for (int ks = 0; ks < 2; ++ks)
#pragma unroll
                for (int nt = 0; nt < 4; ++nt) {
#pragma unroll
                    for (int m = 0; m < 4; ++m) acc[m][nt] = __builtin_amdgcn_mfma_f32_16x16x32_bf16(Af[m][ks], Bfx[ks][nt], acc[m][nt], 0, 0, 0); }
#pragma unroll
            for (int m = 0; m < 4; ++m)
#pragma unroll
                for (int nt = 0; nt < 4; ++nt) { u32x2 o; o.x = pk2(acc[m][nt][0], acc[m][nt][1]); o.y = pk2(acc[m][nt][2], acc[m][nt][3]);
                    *(LAS u32x2*)(lds + wave * (64 * UTS) + (16 * nt + fr) * UTS + (ri * 64 + 16 * m + 4 * fq) * 2) = o; }
        }
        LDS_WAIT(); asm volatile("" ::: "memory");
    } else {
    { u32x4 v[16];
#pragma unroll
      for (int rr = 0; rr < 16; ++rr) { const int k = wave * 16 + rr, ri = k >> 6, idx = k & 63; v[rr] = *(const u32x4*)(src0 + (size_t)idx * src_stride + ri * 512 + lane * 8); }
#pragma unroll
      for (int rr = 0; rr < 16; ++rr) { const int k = wave * 16 + rr; LAS unsigned char* p = lds + k * RS + lane * 16; *(LAS u32x2*)p = (u32x2){v[rr].x, v[rr].y}; *(LAS u32x2*)(p + 8) = (u32x2){v[rr].z, v[rr].w}; } }
    __syncthreads();
    }
#pragma unroll 1
    for (int mp = 0; mp < MTL / 4; ++mp) {
        f32x4 acc[4][4];
#pragma unroll
        for (int m = 0; m < 4; ++m)
#pragma unroll
            for (int n = 0; n < 4; ++n) acc[m][n] = (f32x4){0.f, 0.f, 0.f, 0.f};
        bf16x8 Afr[4][4];
#pragma unroll
        for (int ks = 0; ks < 4; ++ks)
#pragma unroll
            for (int m = 0; m < 4; ++m) Afr[ks][m] = *(const bf16x8*)(Mat + (size_t)(64 * mp + 16 * m + fr) * 128 + 32 * ks + 8 * fq);
#pragma unroll
        for (int ks = 0; ks < 4; ++ks) {
            bf16x8 Bfr[4];
#pragma unroll
            for (int nt = 0; nt < 4; ++nt) {
                if constexpr (EXPAND) Bfr[nt] = *(const LAS bf16x8*)(lds + wave * (64 * UTS) + (16 * nt + fr) * UTS + (32 * ks + 8 * fq) * 2);
                else { const LAS unsigned char* tp = lds + (32 * ks + 8 * fq + (fr >> 2)) * RS + (n0 + 16 * nt + 4 * (fr & 3)) * 2;
                    Bfr[nt] = pk8(lds_tr16(tp), lds_tr16(tp + 4 * RS)); } }
#pragma unroll
            for (int m = 0; m < 4; ++m) {
#pragma unroll
                for (int nt = 0; nt < 4; ++nt) acc[m][nt] = __builtin_amdgcn_mfma_f32_16x16x32_bf16(Afr[ks][m], Bfr[nt], acc[m][nt], 0, 0, 0); }
            __builtin_amdgcn_sched_barrier(0);
        }
#pragma unroll
        for (int m = 0; m < 4; ++m)
#pragma unroll
            for (int nt = 0; nt < 4; ++nt) { const int n = n0 + 16 * nt + fr; const float bv = bvs[nt];
#pragma unroll
                for (int rg = 0; rg < 4; ++rg) { const int mm = 16 * m + 4 * fq + rg; dst0[(size_t)mm * dst_stride + mp * 512 + n] = (bf16_t)f2bf(acc[m][nt][rg] + bv); } }
    }
    if constexpr (EXPAND) { DFT_BAR(); } else { __syncthreads(); }
}
__device__ __forceinline__ void phase4_f1(const Args& a, LAS unsigned char* lds, int vcu, int G, int wave, int lane) {
    const bf16_t* PF = (const bf16_t*)(a.ws + WS_PF); bf16_t* Z1 = (bf16_t*)(a.ws + WS_Z1); const bf16_t* M1 = (const bf16_t*)(a.ws + WS_MAT1); const bf16_t* WU = (const bf16_t*)(a.ws + WS_WU);
    u32x4 pf[8]; bool pfv = false;
    for (int it = vcu; it < 1024; it += G) { const int b = it >> 6, t2 = it & 63; const int nit = it + G; const bf16_t* nsrc = nit < 1024 ? PF + ((size_t)(nit >> 6) * 4096 + (nit & 63)) * 512 : nullptr;
        dft_item<8, true>(lds, PF + ((size_t)b * 4096 + t2) * 512, (size_t)64 * 512, M1, Z1 + ((size_t)b * 4096 + t2) * 1024, (size_t)64 * 1024, nullptr, WU, wave, lane, pf, pfv, nsrc); pfv = true; }
    __syncthreads();
}
__device__ __forceinline__ void phase5_f2(const Args& a, LAS unsigned char* lds, int vcu, int G, int wave, int lane) {
    u32x4 pf2[8];
    const bf16_t* Z1 = (const bf16_t*)(a.ws + WS_Z1); bf16_t* MIX = (bf16_t*)(a.ws + WS_MIX); const bf16_t* M2 = (const bf16_t*)(a.ws + WS_MAT2);
    for (int it = vcu; it < 1024; it += G) { const int b = it >> 6, t1p = it & 63;
        dft_item<4, false>(lds, Z1 + ((size_t)b * 4096 + t1p * 64) * 1024, (size_t)1024, M2 + (size_t)t1p * 64 * 128, MIX + ((size_t)b * 4096 + t1p) * 1024 + 512, (size_t)64 * 1024, a.in[I_BFNO], nullptr, wave, lane, pf2, false, nullptr); }
}

#define P7_STAT(row) (*(const f32x4*)((const float*)(a.ws + WS_LNSTAT) + (size_t)(row) * 2))
#define P7_LOAD(xd, md, row) do { const float* _xr = a.in[I_X] + (size_t)(row) * D; \
    _Pragma("unroll") for (int j = 0; j < 4; ++j) { xd[j] = __builtin_nontemporal_load((const f32x4*)(_xr + 4 * lane + 256 * j)); md[j] = __builtin_nontemporal_load((const u32x2*)(MO + (size_t)(row) * D + 4 * lane + 256 * j)); } } while (0)
template <bool COUNT> __device__ __forceinline__ void phase7(const Args& a, LAS unsigned char* lds, int vcu, int G, int tid, int wave, int lane) {
    const float* MOD = (const float*)(a.ws + WS_MOD); const bf16_t* MO = (const bf16_t*)(a.ws + WS_MO); bf16_t* X1 = (bf16_t*)(a.ws + WS_X1); unsigned char* H2 = a.ws + WS_H2;
    int* TOPI = (int*)(a.ws + WS_TOPI); float* TOPG = (float*)(a.ws + WS_TOPG); unsigned* CTL = (unsigned*)(a.ws + WS_CTL);
    constexpr int HRS = 2064;
    LAS unsigned char* HI = lds; LAS unsigned char* LO = lds + 16 * HRS; LAS float* PART = (LAS float*)(lds + 2 * 16 * HRS);
    LAS int* hist = (LAS int*)(lds + 2 * 16 * HRS + 16384);
    const int fr = lane & 15, fq = lane >> 4;
    bf16x8 Bh[2][4], Bl[2][4];
#pragma unroll
    for (int nt = 0; nt < 2; ++nt)
#pragma unroll
        for (int ks = 0; ks < 4; ++ks)
#pragma unroll
            for (int jj = 0; jj < 8; ++jj) { const float w = a.in[I_WR][(size_t)(128 * wave + 32 * ks + 8 * fq + jj) * 32 + 16 * nt + fr]; const unsigned h = f2bf(w); Bh[nt][ks][jj] = (short)h; Bl[nt][ks][jj] = (short)f2bf(w - bflo(h)); }
    if (tid < 64) hist[tid] = 0;
    const float brl = a.in[I_BR][lane & 31];
    const int TPW = (ML / 16 + G - 1) / G; const int tl0 = vcu * TPW; const int mrw = (tl0 * 16) >> 12;
    LAS float* PV = (LAS float*)(lds + 2 * 16 * HRS + 16384 + 256);
    for (int idx = tid; idx < 1024; idx += 512) { PV[idx] = a.in[I_LN0G][idx] * DN_ALPHA; PV[1024 + idx] = a.in[I_LN0B][idx] * DN_ALPHA; PV[2048 + idx] = MOD[mrw * 6144 + 2048 + idx];
        PV[3072 + idx] = a.in[I_LN1G][idx]; PV[4096 + idx] = a.in[I_LN1B][idx]; PV[5120 + idx] = MOD[mrw * 6144 + 3072 + idx]; PV[6144 + idx] = MOD[mrw * 6144 + 4096 + idx]; }
    __syncthreads();
    f32x4 va[4], vb[4]; u32x2 ma[4], mb[4];
    int tl = tl0; const int tlend = (tl0 + TPW < ML / 16) ? tl0 + TPW : ML / 16;
    f32x4 st = {0.f, 0.f, 0.f, 0.f};
    if (tl < tlend) { P7_LOAD(va, ma, tl * 16 + 2 * wave); P7_LOAD(vb, mb, tl * 16 + 2 * wave + 1); st = P7_STAT(tl * 16 + 2 * wave); }
    for (; tl < tlend; ++tl) {
        const int row0 = tl * 16, ra = row0 + 2 * wave;
        float r1 = st[1], r2 = st[3]; const float c1 = -st[0] * r1, c2 = -st[2] * r2;
        float sa = 0.f, sb = 0.f;
#pragma unroll
        for (int j = 0; j < 4; ++j) { const int c = 4 * lane + 256 * j;
            const f32x4 g = *(const LAS f32x4*)(PV + c), b = *(const LAS f32x4*)(PV + 1024 + c), gt = *(const LAS f32x4*)(PV + 2048 + c);
            const f32x4 moa = {bflo(ma[j].x), bfhi(ma[j].x), bflo(ma[j].y), bfhi(ma[j].y)}, mob = {bflo(mb[j].x), bfhi(mb[j].x), bflo(mb[j].y), bfhi(mb[j].y)};
            va[j] = ((va[j] * r1 + c1) * g + b) + gt * moa; vb[j] = ((vb[j] * r2 + c2) * g + b) + gt * mob;
            sa += (va[j][0] + va[j][1]) + (va[j][2] + va[j][3]); sb += (vb[j][0] + vb[j][1]) + (vb[j][2] + vb[j][3]); }
        float m1 = wave_sum(sa) * (1.f / D), m2 = wave_sum(sb) * (1.f / D); float qa = 0.f, qb = 0.f;
#pragma unroll
        for (int j = 0; j < 4; ++j) { va[j] = va[j] - m1; vb[j] = vb[j] - m2;
            qa += (va[j][0] * va[j][0] + va[j][1] * va[j][1]) + (va[j][2] * va[j][2] + va[j][3] * va[j][3]); qb += (vb[j][0] * vb[j][0] + vb[j][1] * vb[j][1]) + (vb[j][2] * vb[j][2] + vb[j][3] * vb[j][3]); }
        r1 = frsq(wave_sum(qa) * (1.f / D) + LN_EPS); r2 = frsq(wave_sum(qb) * (1.f / D) + LN_EPS);
#pragma unroll
        for (int j = 0; j < 4; ++j) { const int c = 4 * lane + 256 * j;
            const f32x4 g = *(const LAS f32x4*)(PV + 3072 + c), b = *(const LAS f32x4*)(PV + 4096 + c), sh = *(const LAS f32x4*)(PV + 5120 + c), sc = *(const LAS f32x4*)(PV + 6144 + c);
#pragma unroll
            for (int q = 0; q < 2; ++q) { const f32x4 x1 = (q ? vb[j] * r2 : va[j] * r1) * g + b; const int row = ra + q;
                u32x2 o; o.x = pk2(x1[0], x1[1]); o.y = pk2(x1[2], x1[3]); *(GAS u32x2*)(X1 + (size_t)row * D + c) = o;
                const f32x4 h = x1 * (sc + 1.0f) + sh;
                { unsigned w8 = 0u; w8 = __builtin_amdgcn_cvt_pk_fp8_f32(h[0], h[1], w8, false); w8 = __builtin_amdgcn_cvt_pk_fp8_f32(h[2], h[3], w8, true); *(GAS unsigned*)(H2 + (size_t)row * D + c) = w8; }
                u32x2 hw; hw.x = pk2(h[0], h[1]); hw.y = pk2(h[2], h[3]);
                u32x2 lw; lw.x = pk2(h[0] - bflo(hw.x), h[1] - bfhi(hw.x)); lw.y = pk2(h[2] - bflo(hw.y), h[3] - bfhi(hw.y));
                *(LAS u32x2*)(HI + (2 * wave + q) * HRS + c * 2) = hw; *(LAS u32x2*)(LO + (2 * wave + q) * HRS + c * 2) = lw; } }
        asm volatile("" ::: "memory");
        if (tl + 1 < tlend) { P7_LOAD(va, ma, (tl + 1) * 16 + 2 * wave); P7_LOAD(vb, mb, (tl + 1) * 16 + 2 * wave + 1); st = P7_STAT((tl + 1) * 16 + 2 * wave); }
        __syncthreads();
        { f32x4 acc[2] = {{0.f, 0.f, 0.f, 0.f}, {0.f, 0.f, 0.f, 0.f}};
#pragma unroll
          for (int ks = 0; ks < 4; ++ks) { const bf16x8 ah = *(const LAS bf16x8*)(HI + fr * HRS + (128 * wave + 32 * ks + 8 * fq) * 2), al = *(const LAS bf16x8*)(LO + fr * HRS + (128 * wave + 32 * ks + 8 * fq) * 2);
#pragma unroll
              for (int nt = 0; nt < 2; ++nt) { acc[nt] = __builtin_amdgcn_mfma_f32_16x16x32_bf16(ah, Bh[nt][ks], acc[nt], 0, 0, 0); acc[nt] = __builtin_amdgcn_mfma_f32_16x16x32_bf16(ah, Bl[nt][ks], acc[nt], 0, 0, 0); acc[nt] = __builtin_amdgcn_mfma_f32_16x16x32_bf16(al, Bh[nt][ks], acc[nt], 0, 0, 0); } }
#pragma unroll
          for (int nt = 0; nt < 2; ++nt)
#pragma unroll
              for (int rg = 0; rg < 4; ++rg) PART[(wave * 16 + 4 * fq + rg) * 32 + 16 * nt + fr] = acc[nt][rg]; }
        __syncthreads();
        { const int e = lane & 31, rr = lane >> 5; float lg = brl;
#pragma unroll
          for (int w = 0; w < 8; ++w) lg += PART[(w * 16 + 2 * wave + rr) * 32 + e];
          int ti[4]; float tv[4];
#pragma unroll
          for (int k = 0; k < 4; ++k) { float m = lg;
              m = fmaxf(m, dpp_mov<0xB1>(m)); m = fmaxf(m, dpp_mov<0x4E>(m)); m = fmaxf(m, dpp_mov<0x141>(m)); m = fmaxf(m, dpp_mov<0x140>(m));
              { const float up = __builtin_bit_cast(float, __builtin_amdgcn_update_dpp(__builtin_bit_cast(int, m), __builtin_bit_cast(int, m), 0x142, 0xA, 0xF, false)); m = fmaxf(m, up); }
              const float mlo = __builtin_bit_cast(float, __builtin_amdgcn_readlane(__builtin_bit_cast(int, m), 31)), mhi = __builtin_bit_cast(float, __builtin_amdgcn_readlane(__builtin_bit_cast(int, m), 63));
              const float mm = rr ? mhi : mlo;
              const unsigned long long bal = __ballot(lg == mm); const unsigned bl = (unsigned)bal, bh = (unsigned)(bal >> 32);
              const int ilo = bl ? __ffs((int)bl) - 1 : k, ihi = bh ? __ffs((int)bh) - 1 : k;
              const int idx = rr ? ihi : ilo;
              ti[k] = idx; tv[k] = mm; if (e == idx) lg = -3.0e38f; }
          const float e1 = __expf(tv[1] - tv[0]), e2 = __expf(tv[2] - tv[0]), e3 = __expf(tv[3] - tv[0]); const float inv = frcp(1.0f + e1 + e2 + e3);
          if (e == 0) { const int row = ra + rr; *(GAS i32x4*)(TOPI + (size_t)row * 4) = (i32x4){ti[0], ti[1], ti[2], ti[3]}; *(GAS f32x4*)(TOPG + (size_t)row * 4) = (f32x4){inv, e1 * inv, e2 * inv, e3 * inv};
              const int hb = 0;
#pragma unroll
              for (int k = 0; k < 4; ++k) __hip_atomic_fetch_add(hist + hb + ti[k], 1, __ATOMIC_RELAXED, __HIP_MEMORY_SCOPE_WORKGROUP); } }
    }
    __syncthreads();
    if (COUNT && tid < 32) { const int hv = hist[tid]; if (hv) __hip_atomic_fetch_add(CTL + CW_CNT + tid, (unsigned)hv, RLX_AGENT); }
    __syncthreads();
}
#undef P7_LOAD
#undef P7_STAT

__device__ __forceinline__ void phase8(const Args& a, LAS unsigned char* lds, int vcu, int G, int tid) {
    unsigned* CTL = (unsigned*)(a.ws + WS_CTL); const int* TOPI = (const int*)(a.ws + WS_TOPI); int* TOKSLOT = (int*)(a.ws + WS_TOKSLOT); int* SLOTTOK = (int*)(a.ws + WS_SLOTTOK); int* TILEE = (int*)(a.ws + WS_TILEE);
    LAS int* pstart = (LAS int*)lds;
    LAS int* lh = pstart + 64;
    LAS int* lbase = lh + 32;
    LAS int* cnts = lbase + 32;
    if (tid < 32) cnts[tid] = (int)__hip_atomic_load(CTL + CW_CNT + tid, RLX_AGENT);
    __syncthreads();
    if (tid == 0) { int p = 0; for (int e = 0; e < 32; ++e) { pstart[e] = p; p += (cnts[e] + 255) & ~255; } }
    __syncthreads();
    if (vcu == 0) {
        const int tot = pstart[31] + ((cnts[31] + 255) & ~255);
        if (tid == 0) CTL[CW_NT] = (unsigned)(tot >> 8);
        for (int tl = tid; tl < (tot >> 8); tl += 512) { int e = 0;
            for (int q = 1; q < 32; ++q) if (pstart[q] <= tl * 256) e = q;
            TILEE[tl] = e; }
        for (int e = 0; e < 32; ++e) { const int lo = pstart[e] + cnts[e], hi = pstart[e] + ((cnts[e] + 255) & ~255);
            for (int sl = lo + tid; sl < hi; sl += 512) SLOTTOK[sl] = 0; }
    }
    for (int rt = vcu; rt < 256; rt += G) {
        __syncthreads();
        if (tid < 32) lh[tid] = 0;
        __syncthreads();
        int e2[2], lp[2];
#pragma unroll
        for (int z = 0; z < 2; ++z) { const int p = tid * 2 + z; e2[z] = TOPI[(size_t)rt * 1024 + p]; lp[z] = __hip_atomic_fetch_add(lh + e2[z], 1, __ATOMIC_RELAXED, __HIP_MEMORY_SCOPE_WORKGROUP); }
        __syncthreads();
        if (tid < 32) { const int c = lh[tid]; int base = 0; if (c) base = (int)__hip_atomic_fetch_add(CTL + CW_CUR + tid, (unsigned)c, RLX_AGENT); lbase[tid] = pstart[tid] + base; }
        __syncthreads();
#pragma unroll
        for (int z = 0; z < 2; ++z) { const int p = tid * 2 + z; const int slot = lbase[e2[z]] + lp[z]; TOKSLOT[(size_t)rt * 1024 + p] = slot; SLOTTOK[slot] = rt * 256 + (p >> 2); }
    }
}

#define PC_YLOAD(yd, xd, sl, row) do { _Pragma("unroll") for (int k = 0; k < 4; ++k) { const unsigned char* _yr = Yb + (size_t)(sl)[k] * 1024; \
        _Pragma("unroll") for (int j = 0; j < 4; ++j) yd[k][j] = *(const unsigned*)(_yr + 4 * lane + 256 * j); } \
    _Pragma("unroll") for (int j = 0; j < 4; ++j) xd[j] = __builtin_nontemporal_load((const u32x2*)(X1 + (size_t)(row) * D + 4 * lane + 256 * j)); } while (0)
__device__ __forceinline__ void phase_combine(const Args& a, int vcu, int G, int wave, int lane) {
    constexpr int hh = 0, HROWS = ML;
    const float* MOD = (const float*)(a.ws + WS_MOD); const bf16_t* X1 = (const bf16_t*)(a.ws + WS_X1); const unsigned char* Yb = a.ws + WS_Y;
    const int* TOKSLOT = (const int*)(a.ws + WS_TOKSLOT); const float* TOPG = (const float*)(a.ws + WS_TOPG);
    const int gw = vcu * 8 + wave, NGW = G * 8;
    f32x4 g2[4], b2[4];
#pragma unroll
    for (int j = 0; j < 4; ++j) { g2[j] = *(const f32x4*)(a.in[I_LN2G] + 4 * lane + 256 * j); b2[j] = *(const f32x4*)(a.in[I_LN2B] + 4 * lane + 256 * j); }
    int rr = gw; if (rr >= HROWS) return;
    i32x4 sl0 = *(const i32x4*)(TOKSLOT + (size_t)(hh * HROWS + rr) * 4); f32x4 gg0 = *(const f32x4*)(TOPG + (size_t)(hh * HROWS + rr) * 4);
    unsigned y0[4][4]; u32x2 x0[4];
    PC_YLOAD(y0, x0, sl0, hh * HROWS + rr);
    i32x4 sl1 = sl0; f32x4 gg1 = gg0;
    if (rr + NGW < HROWS) { sl1 = *(const i32x4*)(TOKSLOT + (size_t)(hh * HROWS + rr + NGW) * 4); gg1 = *(const f32x4*)(TOPG + (size_t)(hh * HROWS + rr + NGW) * 4); }
    for (; rr < HROWS; rr += NGW) { const int row = hh * HROWS + rr, mr = row >> 12;
        unsigned y1[4][4]; u32x2 x1n[4]; i32x4 sl2 = sl1; f32x4 gg2 = gg1; f32x4 gtv[4];
#pragma unroll
        for (int j = 0; j < 4; ++j) gtv[j] = *(const f32x4*)(MOD + mr * 6144 + 5120 + 4 * lane + 256 * j);
        asm volatile("" ::: "memory");
        if (rr + NGW < HROWS) { PC_YLOAD(y1, x1n, sl1, row + NGW); }
        if (rr + 2 * NGW < HROWS) { sl2 = *(const i32x4*)(TOKSLOT + (size_t)(row + 2 * NGW) * 4); gg2 = *(const f32x4*)(TOPG + (size_t)(row + 2 * NGW) * 4); }
        f32x4 v[4]; float s = 0.f;
#pragma unroll
        for (int j = 0; j < 4; ++j) { const int c = 4 * lane + 256 * j; f32x4 f = {0.f, 0.f, 0.f, 0.f};
#pragma unroll
            for (int k = 0; k < 4; ++k) { const f32x2 ylo = __builtin_amdgcn_cvt_pk_f32_fp8(y0[k][j], false), yhi = __builtin_amdgcn_cvt_pk_f32_fp8(y0[k][j], true); f += (f32x4){ylo[0], ylo[1], yhi[0], yhi[1]} * gg0[k]; }
            const f32x4 gt = gtv[j];
            v[j] = (f32x4){bflo(x0[j].x), bfhi(x0[j].x), bflo(x0[j].y), bfhi(x0[j].y)} * DN_ALPHA + gt * f; s += (v[j][0] + v[j][1]) + (v[j][2] + v[j][3]); }
        const float mean = wave_sum(s) * (1.f / D); float s2 = 0.f;
#pragma unroll
        for (int j = 0; j < 4; ++j) { v[j] = v[j] - mean; s2 += (v[j][0] * v[j][0] + v[j][1] * v[j][1]) + (v[j][2] * v[j][2] + v[j][3] * v[j][3]); }
        const float rstd = frsq(wave_sum(s2) * (1.f / D) + LN_EPS);
#pragma unroll
        for (int j = 0; j < 4; ++j) { const int c = 4 * lane + 256 * j; __builtin_nontemporal_store(v[j] * rstd * g2[j] + b2[j], (f32x4*)(a.out + (size_t)row * D + c)); }
#pragma unroll
        for (int k = 0; k < 4; ++k)
#pragma unroll
            for (int j = 0; j < 4; ++j) y0[k][j] = y1[k][j];
#pragma unroll
        for (int j = 0; j < 4; ++j) x0[j] = x1n[j];
        gg0 = gg1; sl1 = sl2; gg1 = gg2;
    }
}
#undef PC_YLOAD
#ifndef MK_N_LAUNCHES
#define MK_N_LAUNCHES 1
#endif
constexpr int NPH = 12;
__global__ void __launch_bounds__(512, 2) fwd_kernel(Args args) {
    extern __shared__ __attribute__((aligned(16))) unsigned char lds_raw[];
    LAS unsigned char* lds = (LAS unsigned char*)lds_raw;
    volatile LAS unsigned* MISC = (volatile LAS unsigned*)(lds + MISC_OFF);
    const int tid = threadIdx.x, lane = tid & 63, wave = __builtin_amdgcn_readfirstlane(tid >> 6);
    const int G = gridDim.x; const int bx = blockIdx.x; const int vcu = (G % 8 == 0) ? (bx % 8) * (G / 8) + bx / 8 : bx;
    unsigned char* ws = args.ws; unsigned* CTL = (unsigned*)(ws + WS_CTL);
    if (tid < 64) MISC[tid] = 0u;
    __syncthreads();
    const int lo = args.ph_lo, hi = args.ph_hi;
    XcdBarrier bar; bar.bar = CTL + CW_BAR; bar.x = 0; bar.st = nullptr;
    if (hi - lo > 1) bar = xcd_barrier_post(CTL + CW_BAR, MISC + 8);
#ifdef PH_ONLY
#define IN(k) ((k) == PH_ONLY && lo <= (k) && (k) < hi)
#else
#define IN(k) (lo <= (k) && (k) < hi)
#endif
#define SEAM(k) do { if (IN(k) && IN((k) + 1)) xcd_barrier(bar); } while (0)

    if (IN(0)) {
        phase0(args, lds, vcu, G, tid, wave, lane);
    }
    SEAM(0);
    if (IN(1)) {
        phase1(args, vcu, G, wave, lane);
    }
    SEAM(1);
    if (IN(2)) {
        { pg8::Gemm g{ws + WS_H, ws + WS_WINT, 2048, 2048, nullptr};
          SchedInProj S; S.init(G, bx);
          EpiInProj E{(bf16_t*)(ws + WS_PS), (bf16_t*)(ws + WS_PF)};
          pg8::gemm_phase<EpiInProj, SchedInProj, false, false>(lds, g, S, E); }
    }
    SEAM(2);
    if (IN(3)) {
        phase3_shift(args, vcu, G, tid);
    }
    SEAM(3);
    if (IN(4)) {
        phase4_scan(args, lds, vcu, G, tid, wave, lane);
        phase4_f1(args, lds, vcu, G, wave, lane);
    }
    SEAM(4);
    if (IN(5)) {
        { pg8::Gemm g{ws + WS_MS + 1792 * 2, ws + WS_GATEBT, 4096, 512, nullptr};
          SchedGrid S; S.init(ML / 256, 4, G, bx);
          EpiGate E{(const bf16_t*)(ws + WS_Z), (bf16_t*)(ws + WS_MIX)};
          pg8::gemm_phase<EpiGate, SchedGrid, false, false>(lds, g, S, E); }
        __syncthreads();
        phase5_f2(args, lds, vcu, G, wave, lane);
    }
    SEAM(5);
    if (IN(6)) {
        { pg8::Gemm g{ws + WS_MIX, ws + WS_WOUTT, 2048, 2048, nullptr};
          SchedGrid S; S.init(ML / 256, 4, G, bx);
          EpiBf16Plain E{(bf16_t*)(ws + WS_MO), 1024};
          pg8::gemm_phase<EpiBf16Plain, SchedGrid, false, false>(lds, g, S, E); }
    }
    SEAM(6);
    if (IN(7)) {
        phase7<true>(args, lds, vcu, G, tid, wave, lane);
    }
    SEAM(7);
    if (IN(8)) { phase8(args, lds, vcu, G, tid); }
    SEAM(8);
    if (IN(9)) {
        LAS int* te = (LAS int*)(lds + RING_BYTES); const int ntl = (int)__hip_atomic_load(CTL + CW_NT, RLX_AGENT);
        for (int q = tid; q < ntl; q += 512) te[q] = ((const int*)(ws + WS_TILEE))[q];
        __syncthreads();
        { pg8::Gemm g{ws + WS_H2, (unsigned char*)args.out + OUT_W1T, 1024, 1024, (const int*)(ws + WS_SLOTTOK)};
          SchedMoE S{G, bx, 8, ntl, te, false};
          EpiSwiGLU E{(unsigned char*)(ws + WS_ACT), args.in[I_B1]};
          pg8::gemm_phase<EpiSwiGLU, SchedMoE, true, true>(lds, g, S, E); }
    }
    SEAM(9);
    if (IN(10)) {
        LAS int* te = (LAS int*)(lds + RING_BYTES); const int ntl = (int)__hip_atomic_load(CTL + CW_NT, RLX_AGENT);
        for (int q = tid; q < ntl; q += 512) te[q] = ((const int*)(ws + WS_TILEE))[q];
        __syncthreads();
        { pg8::Gemm g{ws + WS_ACT, ws + WS_W2T, 1024, 1024, nullptr};
          SchedMoE S{G, bx, 4, ntl, te, true};
          EpiY E{ws + WS_Y, args.in[I_B2]};
          pg8::gemm_phase<EpiY, SchedMoE, false, true>(lds, g, S, E); }
    }
    SEAM(10);
    if (IN(11)) {
        phase_combine(args, vcu, G, wave, lane);
    }
#undef IN
#undef SEAM
}

extern "C" void kernel_launch(void* const* d_in, const int* in_sizes, int n_in, void* d_out, int out_size, void* d_ws, size_t ws_size, hipStream_t stream) {
    static int grid = 0;
    if (grid == 0) {
        if (n_in != 33 || out_size != ML * D || ws_size < WS_END) { fprintf(stderr, "kernel_launch: unexpected shapes (n_in %d, out %d, ws %zu); nothing launched\n", n_in, out_size, ws_size); grid = -1; return; }
        int dev = 0, cus = 0, per_cu = 0;
        if (hipGetDevice(&dev) != hipSuccess || hipDeviceGetAttribute(&cus, hipDeviceAttributeMultiprocessorCount, dev) != hipSuccess) { grid = -1; return; }
        if (hipFuncSetAttribute((const void*)fwd_kernel, hipFuncAttributeMaxDynamicSharedMemorySize, LDS_BYTES) != hipSuccess) { fprintf(stderr, "kernel_launch: hipFuncSetAttribute failed\n"); grid = -1; return; }
        if (hipOccupancyMaxActiveBlocksPerMultiprocessor(&per_cu, (const void*)fwd_kernel, 512, LDS_BYTES) != hipSuccess || per_cu < 1) { fprintf(stderr, "kernel_launch: occupancy query says %d\n", per_cu); }
        (void)hipGetLastError();
        grid = cus;
    }
    if (grid < 0) return;
    if (hipMemsetAsync((char*)d_ws + WS_CTL, 0, CTL_ZERO_BYTES, stream) != hipSuccess) return;
    Args a{};
    for (int i = 0; i < 33; ++i) a.in[i] = (const float*)d_in[i];
    a.out = (float*)d_out; a.ws = (unsigned char*)d_ws;
#if MK_N_LAUNCHES == 1
    a.ph_lo = 0; a.ph_hi = NPH;
    hipLaunchKernelGGL(fwd_kernel, dim3(grid), dim3(512), LDS_BYTES, stream, a);
#else
    for (int p = 0; p < NPH; ++p) { a.ph_lo = p; a.ph_hi = p + 1; hipLaunchKernelGGL(fwd_kernel, dim3(grid), dim3(512), LDS_BYTES, stream, a); }
#endif
}
```
